# Optimizing an MI355X kernel written in HIP

```python
import math
import jax
import jax.numpy as jnp
from jax import lax
import numpy as np

D_MODEL = 2048
BATCH = 2
SEQ = 8192
DEPTH = 4

HEAD_DIM = 64
EPS = 1e-6
NA_HEADS = 8
NA_KH = 8
NA_KW = 16
GRID_W = 64
WA_Q_HEADS = 8
WA_KV_HEADS = 2
WINDOW = 128
WA_BLOCK = 128
ROPE_THETA = 500000.0
ROPE_DIM = HEAD_DIM // 4
SSM_HEADS = 8
SSM_HEAD_DIM = 64
SSM_GROUPS = 2
SSM_STATE = 128
SSM_CONV = 5
SSM_CHUNK = 128
CONF_WIDTH = 512
CONF_KERNEL = 31
NA_WIDTH = NA_HEADS * HEAD_DIM
WA_Q_WIDTH = WA_Q_HEADS * HEAD_DIM
WA_KV_WIDTH = WA_KV_HEADS * HEAD_DIM
SSM_WIDTH = SSM_HEADS * SSM_HEAD_DIM
SSM_BC_WIDTH = SSM_GROUPS * SSM_STATE
SSM_XBC_WIDTH = SSM_WIDTH + 2 * SSM_BC_WIDTH
D_MIX = NA_WIDTH + WA_Q_WIDTH + SSM_WIDTH + CONF_WIDTH
IN_SPLITS = (NA_WIDTH, NA_WIDTH, NA_WIDTH, WA_Q_WIDTH, WA_KV_WIDTH, WA_KV_WIDTH,
             SSM_WIDTH, SSM_XBC_WIDTH, 2 * SSM_HEADS, 2 * CONF_WIDTH)
IN_WIDTH = (3 * NA_WIDTH + WA_Q_WIDTH + 2 * WA_KV_WIDTH + SSM_WIDTH + SSM_XBC_WIDTH
            + 2 * SSM_HEADS + 2 * CONF_WIDTH)
N_EXPERTS = 16
EC_CAPACITY = 2
EXPERT_FF = D_MODEL // 2

kernel_name = 'hybrid_na2d_swa_ssd_conv_ec_encoder'


def _rms(x, w):
    xf = x.astype(jnp.float32)
    y = xf * lax.rsqrt(jnp.mean(xf * xf, axis=-1, keepdims=True) + EPS)
    return (y * w.astype(jnp.float32)).astype(x.dtype)


def _layer_norm(x, w, b):
    xf = x.astype(jnp.float32)
    mu = jnp.mean(xf, axis=-1, keepdims=True)
    var = jnp.mean(jnp.square(xf - mu), axis=-1, keepdims=True)
    y = (xf - mu) * lax.rsqrt(var + EPS)
    return (y * w.astype(jnp.float32) + b.astype(jnp.float32)).astype(x.dtype)


def _dwconv(x, w, b):
    k = w.shape[0]
    left = (k - 1) // 2
    y = lax.conv_general_dilated(x, w[:, None, :].astype(x.dtype), window_strides=(1,),
                                 padding=[(left, k - 1 - left)],
                                 dimension_numbers=('NWC', 'WIO', 'NWC'),
                                 feature_group_count=x.shape[-1])
    return y + b.astype(x.dtype)


def _split_cols(u):
    offs = np.cumsum(np.array(IN_SPLITS))[:-1].tolist()
    return jnp.split(u, offs, axis=-1)


def _partial_rope(x, pos):
    half = ROPE_DIM // 2
    inv_freq = 1.0 / (ROPE_THETA ** (jnp.arange(half, dtype=jnp.float32) * 2.0 / ROPE_DIM))
    ang = pos.astype(jnp.float32)[:, None] * inv_freq[None, :]
    cos = jnp.cos(ang)[None, :, None, :]
    sin = jnp.sin(ang)[None, :, None, :]
    xf = x[..., :ROPE_DIM].astype(jnp.float32)
    x1, x2 = xf[..., :half], xf[..., half:]
    rot = jnp.concatenate([x1 * cos - x2 * sin, x2 * cos + x1 * sin], axis=-1).astype(x.dtype)
    return jnp.concatenate([rot, x[..., ROPE_DIM:]], axis=-1)


def _neighbourhood_attention(q, k, v, rpb):
    bsz, s, h, d = q.shape
    rows = s // GRID_W
    kh = min(NA_KH, rows)
    q = (q * d ** -0.5).reshape(bsz, rows, GRID_W, h, d)
    k = k.reshape(bsz, rows, GRID_W, h, d)
    v = v.reshape(bsz, rows, GRID_W, h, d)
    col = jnp.arange(GRID_W)
    col_idx = jnp.clip(col - NA_KW // 2, 0, GRID_W - NA_KW)[:, None] + jnp.arange(NA_KW)[None, :]
    bias_cols = rpb[:, :, col_idx - col[:, None] + NA_KW - 1]

    def one_row(r):
        r0 = jnp.clip(r - kh // 2, 0, rows - kh)
        k_win = lax.dynamic_slice_in_dim(k, r0, kh, axis=1)[:, :, col_idx]
        v_win = lax.dynamic_slice_in_dim(v, r0, kh, axis=1)[:, :, col_idx]
        q_r = lax.dynamic_index_in_dim(q, r, axis=1, keepdims=False)
        bias = bias_cols[:, r0 + jnp.arange(kh) - r + NA_KH - 1]
        logits = (jnp.einsum('bqhd,brqkhd->bhqrk', q_r, k_win).astype(jnp.float32)
                  + jnp.transpose(bias, (0, 2, 1, 3)).astype(jnp.float32))
        p = jax.nn.softmax(logits.reshape(bsz, h, GRID_W, kh * NA_KW), axis=-1).reshape(logits.shape)
        return jnp.einsum('bhqrk,brqkhd->bqhd', p.astype(v.dtype), v_win)

    out = lax.map(one_row, jnp.arange(rows))
    return jnp.transpose(out, (1, 0, 2, 3, 4)).reshape(bsz, s, h * d)


def _window_attention(q, k, v, sink):
    bsz, s, hq, d = q.shape
    hkv = k.shape[2]
    g = hq // hkv
    nb = s // WA_BLOCK
    qb = (q * d ** -0.5).reshape(bsz, nb, WA_BLOCK, hkv, g, d)

    def band(t):
        tp = jnp.pad(t, ((0, 0), (WA_BLOCK, WA_BLOCK), (0, 0), (0, 0))).reshape(bsz, nb + 2, WA_BLOCK, hkv, d)
        return jnp.concatenate([tp[:, :-2], tp[:, 1:-1], tp[:, 2:]], axis=2)

    kb, vb = band(k), band(v)
    qi = jnp.arange(WA_BLOCK)[:, None]
    kj = jnp.arange(3 * WA_BLOCK)[None, :]
    kpos = (jnp.arange(nb) * WA_BLOCK - WA_BLOCK)[:, None, None] + kj[None]
    mask = (jnp.abs(kj - WA_BLOCK - qi)[None] <= WINDOW) & (kpos >= 0) & (kpos < s)
    logits = jnp.einsum('bnqhgd,bnkhd->bhgnqk', qb, kb).astype(jnp.float32)
    logits = jnp.where(mask, logits, -jnp.inf)
    sink_l = jnp.broadcast_to(sink.astype(jnp.float32).reshape(1, hkv, g, 1, 1, 1), logits.shape[:-1] + (1,))
    p = jax.nn.softmax(jnp.concatenate([logits, sink_l], axis=-1), axis=-1)[..., :-1]
    o = jnp.einsum('bhgnqk,bnkhd->bnqhgd', p.astype(v.dtype), vb)
    return o.reshape(bsz, s, hq * d)


def _ssd(x, dt, a, bm, cm):
    bsz, s, h, p = x.shape
    L = SSM_CHUNK
    nc = s // L
    hg = h // SSM_GROUPS
    xc = (x * dt[..., None]).reshape(bsz, nc, L, SSM_GROUPS, hg, p)
    ac = (dt * a).reshape(bsz, nc, L, SSM_GROUPS, hg)
    bc = bm.reshape(bsz, nc, L, SSM_GROUPS, SSM_STATE)
    cc = cm.reshape(bsz, nc, L, SSM_GROUPS, SSM_STATE)
    a_cum = jnp.cumsum(ac, axis=2)
    tri = jnp.tril(jnp.ones((L, L), dtype=bool))[None, None, :, :, None, None]
    seg = a_cum[:, :, :, None] - a_cum[:, :, None, :]
    decay = jnp.exp(jnp.where(tri, seg, -jnp.inf))
    cb = jnp.einsum('bclgn,bcsgn->bclsg', cc, bc)
    y_diag = jnp.einsum('bclsg,bclsgh,bcsghp->bclghp', cb, decay, xc)
    decay_states = jnp.exp(a_cum[:, :, -1:] - a_cum)
    states = jnp.einsum('bclgn,bclgh,bclghp->bcghpn', bc, decay_states, xc)
    chunk_decay = jnp.exp(a_cum[:, :, -1])

    def step(hstate, inp):
        dec, st = inp
        return dec[..., None, None] * hstate + st, hstate

    h0 = jnp.zeros((bsz, SSM_GROUPS, hg, p, SSM_STATE), jnp.float32)
    _, prev = lax.scan(step, h0, (jnp.moveaxis(chunk_decay, 1, 0), jnp.moveaxis(states, 1, 0)))
    prev = jnp.moveaxis(prev, 0, 1)
    y_off = jnp.einsum('bclgn,bcghpn,bclgh->bclghp', cc, prev, jnp.exp(a_cum))
    return (y_diag + y_off).reshape(bsz, s, h, p)


def _expert_choice_ffn(h, w_router, w_gate, w_up, w_down):
    bsz, s, dm = h.shape
    cap = EC_CAPACITY * s // N_EXPERTS
    aff = jax.nn.softmax(jnp.einsum('bsd,de->bse', h, w_router).astype(jnp.float32), axis=-1)
    gate, idx = lax.top_k(jnp.swapaxes(aff, 1, 2), cap)
    xin = jax.vmap(lambda hb, ib: hb[ib])(h, idx)
    hid = jax.nn.silu(jnp.einsum('becd,edf->becf', xin, w_gate)) * jnp.einsum('becd,edf->becf', xin, w_up)
    out = jnp.einsum('becf,efd->becd', hid, w_down) * gate[..., None].astype(h.dtype)
    return jax.vmap(lambda ob, ib: jnp.zeros((s, dm), ob.dtype).at[ib.reshape(-1)].add(ob.reshape(-1, dm)))(out, idx)


def _mixing_sublayer(x, norm_w, w_in, na_q_norm, na_k_norm, na_rpb, wa_q_norm, wa_k_norm, wa_sink,
                     ssm_conv_w, ssm_conv_b, ssm_dt_bias, ssm_a_log, ssm_d, ssm_norm_w,
                     conf_dw_w, conf_dw_b, conf_ln_w, conf_ln_b, w_out):
    bsz, s, _ = x.shape
    hn = _rms(x, norm_w)
    u = jnp.einsum('bsd,de->bse', hn, w_in)
    na_q, na_k, na_v, wa_q, wa_k, wa_v, ssm_z, ssm_xbc, ssm_dt, conf_in = _split_cols(u)

    def heads(t):
        return t.reshape(bsz, s, -1, HEAD_DIM)

    o_a = _neighbourhood_attention(_rms(heads(na_q), na_q_norm), _rms(heads(na_k), na_k_norm), heads(na_v), na_rpb)

    pos = jnp.arange(s)
    o_b = _window_attention(_partial_rope(_rms(heads(wa_q), wa_q_norm), pos),
                            _partial_rope(_rms(heads(wa_k), wa_k_norm), pos),
                            heads(wa_v), wa_sink)

    xbc = jax.nn.silu(_dwconv(ssm_xbc, ssm_conv_w, ssm_conv_b)).astype(jnp.float32)
    xs = xbc[..., :SSM_WIDTH].reshape(bsz, s, SSM_HEADS, SSM_HEAD_DIM)
    bm = xbc[..., SSM_WIDTH:SSM_WIDTH + SSM_BC_WIDTH].reshape(bsz, s, SSM_GROUPS, SSM_STATE)
    cm = xbc[..., SSM_WIDTH + SSM_BC_WIDTH:].reshape(bsz, s, SSM_GROUPS, SSM_STATE)
    dt = jax.nn.softplus(ssm_dt.astype(jnp.float32).reshape(bsz, s, 2, SSM_HEADS) + ssm_dt_bias.astype(jnp.float32))
    a = -jnp.exp(ssm_a_log.astype(jnp.float32))

    def flip(t):
        return jnp.flip(t, axis=1)

    y_fwd = _ssd(xs, dt[:, :, 0], a[0], bm, cm)
    y_bwd = flip(_ssd(flip(xs), flip(dt[:, :, 1]), a[1], flip(bm), flip(cm)))
    y = (y_fwd + y_bwd + xs * ssm_d.astype(jnp.float32)[:, None]).reshape(bsz, s, SSM_WIDTH).astype(x.dtype)
    o_c = _rms(y * jax.nn.silu(ssm_z), ssm_norm_w)

    c_a, c_g = jnp.split(conf_in, 2, axis=-1)
    cv = _dwconv(c_a * jax.nn.sigmoid(c_g), conf_dw_w, conf_dw_b)
    o_d = jax.nn.silu(_layer_norm(cv, conf_ln_w, conf_ln_b))

    mixed = jnp.concatenate([o_a, o_b, o_c, o_d], axis=-1)
    return x + jnp.einsum('bse,ed->bsd', mixed, w_out)


def setup_inputs(seed: int = 0) -> dict:
    key = jax.random.key(seed)
    ks = jax.random.split(key, 26)
    f32 = jnp.float32
    L = DEPTH

    def nrm(k, shape, sc):
        return jax.random.normal(k, shape, f32) * sc

    def gain(k, shape):
        return 1.0 + 0.02 * jax.random.normal(k, shape, f32)

    dt0 = jnp.exp(jax.random.uniform(ks[12], (L, 2, SSM_HEADS), f32, math.log(1e-3), math.log(1e-1)))
    return {
        'x': jax.random.normal(ks[0], (BATCH, SEQ, D_MODEL), f32),
        'mix_norm_w': gain(ks[1], (L, D_MODEL)),
        'w_in': nrm(ks[2], (L, D_MODEL, IN_WIDTH), D_MODEL ** -0.5),
        'na_q_norm': gain(ks[3], (L, HEAD_DIM)),
        'na_k_norm': gain(ks[4], (L, HEAD_DIM)),
        'na_rpb': nrm(ks[5], (L, NA_HEADS, 2 * NA_KH - 1, 2 * NA_KW - 1), 0.1),
        'wa_q_norm': gain(ks[6], (L, HEAD_DIM)),
        'wa_k_norm': gain(ks[7], (L, HEAD_DIM)),
        'wa_sink': nrm(ks[8], (L, WA_Q_HEADS), 0.5),
        'ssm_conv_w': nrm(ks[9], (L, SSM_CONV, SSM_XBC_WIDTH), SSM_CONV ** -0.5),
        'ssm_conv_b': nrm(ks[10], (L, SSM_XBC_WIDTH), 0.02),
        'ssm_dt_bias': dt0 + jnp.log(-jnp.expm1(-dt0)),
        'ssm_a_log': jnp.log(jax.random.uniform(ks[13], (L, 2, SSM_HEADS), f32, 1.0, 16.0)),
        'ssm_d': gain(ks[14], (L, SSM_HEADS)),
        'ssm_norm_w': gain(ks[15], (L, SSM_WIDTH)),
        'conf_dw_w': nrm(ks[16], (L, CONF_KERNEL, CONF_WIDTH), CONF_KERNEL ** -0.5),
        'conf_dw_b': nrm(ks[17], (L, CONF_WIDTH), 0.02),
        'conf_ln_w': gain(ks[18], (L, CONF_WIDTH)),
        'conf_ln_b': nrm(ks[19], (L, CONF_WIDTH), 0.02),
        'w_out': nrm(ks[20], (L, D_MIX, D_MODEL), D_MIX ** -0.5),
        'ffn_norm_w': gain(ks[21], (L, D_MODEL)),
        'w_router': nrm(ks[22], (L, D_MODEL, N_EXPERTS), D_MODEL ** -0.5),
        'w_gate': nrm(ks[23], (L, N_EXPERTS, D_MODEL, EXPERT_FF), D_MODEL ** -0.5),
        'w_up': nrm(ks[24], (L, N_EXPERTS, D_MODEL, EXPERT_FF), D_MODEL ** -0.5),
        'w_down': nrm(ks[25], (L, N_EXPERTS, EXPERT_FF, D_MODEL), EXPERT_FF ** -0.5),
    }


def reference(x, mix_norm_w, w_in, na_q_norm, na_k_norm, na_rpb, wa_q_norm, wa_k_norm, wa_sink,
              ssm_conv_w, ssm_conv_b, ssm_dt_bias, ssm_a_log, ssm_d, ssm_norm_w,
              conf_dw_w, conf_dw_b, conf_ln_w, conf_ln_b, w_out,
              ffn_norm_w, w_router, w_gate, w_up, w_down):
    for l in range(DEPTH):
        x = _mixing_sublayer(x, mix_norm_w[l], w_in[l], na_q_norm[l], na_k_norm[l], na_rpb[l],
                             wa_q_norm[l], wa_k_norm[l], wa_sink[l],
                             ssm_conv_w[l], ssm_conv_b[l], ssm_dt_bias[l], ssm_a_log[l], ssm_d[l], ssm_norm_w[l],
                             conf_dw_w[l], conf_dw_b[l], conf_ln_w[l], conf_ln_b[l], w_out[l])
        x = x + _expert_choice_ffn(_rms(x, ffn_norm_w[l]), w_router[l], w_gate[l], w_up[l], w_down[l])
    return x
```

```cpp
#define FAST_CONF 1
#define FAST_NA 1
#define FAST_SWA 1
#define FAST_SSD 1
#include <hip/hip_runtime.h>
#include <cstdio>
#include <cstdint>

#ifndef MK_MULTI
#define MK_MULTI 0
#endif
#ifndef FAST_SSD
#define FAST_SSD 0
#endif
#ifndef FAST_SWA
#define FAST_SWA 0
#endif
#ifndef FAST_NA
#define FAST_NA 0
#endif

#define GAS __attribute__((address_space(1)))
#define LAS __attribute__((address_space(3)))
typedef unsigned short bf16_t;
typedef short bf16x8 __attribute__((ext_vector_type(8)));
typedef float f32x4 __attribute__((ext_vector_type(4)));
typedef float f32x2 __attribute__((ext_vector_type(2)));
typedef unsigned u32x4 __attribute__((ext_vector_type(4)));
typedef unsigned u32x2 __attribute__((ext_vector_type(2)));
typedef __bf16 bf16x2_t __attribute__((ext_vector_type(2)));
typedef GAS unsigned gu32;

constexpr int SEQ = 8192, NB = 2, T = NB * SEQ, DM = 2048, DEPTH = 4;
constexpr int INW = 4880;
constexpr int NU = 5120;
constexpr int U_NAQ = 0, U_NAK = 512, U_NAV = 1024, U_WAQ = 1536, U_WAK = 2048, U_WAV = 2176, U_Z = 2304, U_XBC = 2816, U_CA = 3840, U_CG = 4352, U_DT = 4864;
constexpr int NEXP = 16, CAP = 1024, FF = 1024, NSLOT = NB * NEXP * CAP;
constexpr float EPS = 1e-6f;

constexpr size_t MiB = 1u << 20;
constexpr size_t WS_CTL = 0, CTL_ZERO_BYTES = 1 * MiB;
constexpr size_t WS_WIN = 2 * MiB;
constexpr size_t WS_WOUT = WS_WIN + 80 * MiB;
constexpr size_t WS_WGU = WS_WOUT + 32 * MiB;
constexpr size_t WS_WDN = WS_WGU + 512 * MiB;
constexpr size_t WS_HN = WS_WDN + 256 * MiB;
constexpr size_t WS_U = WS_HN + 64 * MiB;
constexpr size_t WS_MIX = WS_U + 160 * MiB;
constexpr size_t WS_HID = WS_MIX + 64 * MiB;
constexpr size_t WS_Y = WS_HID + 64 * MiB;
constexpr size_t WS_XBC = WS_Y + 128 * MiB;
constexpr size_t WS_YSSD = WS_XBC + 64 * MiB;
constexpr size_t WS_STATE = WS_YSSD + 64 * MiB;
constexpr size_t WS_DTRAW = WS_STATE + 64 * MiB;
constexpr size_t WS_DT = WS_DTRAW + 1 * MiB;
constexpr size_t WS_AFF = WS_DT + 1 * MiB;
constexpr size_t WS_SEL = WS_AFF + 1 * MiB;
constexpr size_t WS_RMAP = WS_SEL + 1 * MiB;
constexpr size_t WS_GATE = WS_RMAP + 1 * MiB;
constexpr size_t WS_ROPE = WS_GATE + 1 * MiB;
constexpr size_t WS_CDEC = WS_ROPE + 1 * MiB;
constexpr size_t WS_PREV = WS_CDEC + 1 * MiB;
constexpr size_t WS_XR = WS_PREV + 32 * MiB;
constexpr size_t WS_RSTD = WS_XR + 64 * MiB;
constexpr size_t WS_RSTD1 = WS_RSTD + 1 * MiB;
constexpr size_t WS_RTW = WS_RSTD1 + 1 * MiB;
constexpr size_t WS_END = WS_RTW + 1 * MiB;

constexpr int CW_BAR = 4096;

constexpr int RING_BYTES = 131072;
constexpr int LDS_BYTES = 163840;
constexpr int LDSCTL_OFF = LDS_BYTES - 1024;
constexpr int MISC_OFF = LDSCTL_OFF + 320;
constexpr int RMAPL_OFF = LDSCTL_OFF - 8192;
constexpr int RSTDL_OFF = RMAPL_OFF - 8192;
static_assert(RSTDL_OFF >= RING_BYTES && RMAPL_OFF >= RING_BYTES && MISC_OFF + 128 <= LDS_BYTES, "LDS map");

__device__ __forceinline__ int lane_opq() { int l; asm volatile("v_mbcnt_lo_u32_b32 %0, -1, 0\n\tv_mbcnt_hi_u32_b32 %0, -1, %0" : "=v"(l)); return l; }
__device__ __forceinline__ float shx(float v, int m) { return __int_as_float(__builtin_amdgcn_ds_bpermute((lane_opq() ^ m) << 2, __float_as_int(v))); }
__device__ __forceinline__ int shup_i(int v, int o) { const int l = lane_opq(); return __builtin_amdgcn_ds_bpermute((l >= o ? l - o : l) << 2, v); }
__device__ __forceinline__ int shdn_i(int v, int o) { const int l = lane_opq(); return __builtin_amdgcn_ds_bpermute((l + o < 64 ? l + o : l) << 2, v); }
__device__ __forceinline__ float shup_f(float v, int o) { return __int_as_float(shup_i(__float_as_int(v), o)); }
__device__ __forceinline__ int shl_i(int v, int src) { return __builtin_amdgcn_readlane(v, __builtin_amdgcn_readfirstlane(src)); }
__device__ __forceinline__ float shl_f(float v, int src) { return __int_as_float(__builtin_amdgcn_readlane(__float_as_int(v), __builtin_amdgcn_readfirstlane(src))); }
#define LBAR() asm volatile("s_waitcnt lgkmcnt(0)\n\ts_barrier" ::: "memory")
__device__ __forceinline__ unsigned cvtpk(float lo, float hi) { f32x2 v = {lo, hi}; bf16x2_t b = __builtin_convertvector(v, bf16x2_t); return __builtin_bit_cast(unsigned, b); }
__device__ __forceinline__ float bflo(unsigned w) { return __uint_as_float(w << 16); }
__device__ __forceinline__ float bfhi(unsigned w) { return __uint_as_float(w & 0xffff0000u); }
__device__ __forceinline__ float bf1(bf16_t h) { return __uint_as_float(((unsigned)h) << 16); }
__device__ __forceinline__ float wsum(float v) {
    { const int l = lane_opq();
#pragma unroll
      for (int o = 1; o < 64; o <<= 1) v += __int_as_float(__builtin_amdgcn_ds_bpermute((l ^ o) << 2, __float_as_int(v))); }
    return v;
}
__device__ __forceinline__ float wmax(float v) {
    { const int l = lane_opq();
#pragma unroll
      for (int o = 1; o < 64; o <<= 1) v = fmaxf(v, __int_as_float(__builtin_amdgcn_ds_bpermute((l ^ o) << 2, __float_as_int(v)))); }
    return v;
}
__device__ __forceinline__ float sigmoidf_(float x) { return __builtin_amdgcn_rcpf(1.0f + __expf(-x)); }
__device__ __forceinline__ float siluf_(float x) { return x * __builtin_amdgcn_rcpf(1.0f + __expf(-x)); }
__device__ __forceinline__ float softplusf_(float x) {
    if (x > 20.f) return x;
    const float e = __expf(x);
    if (e < 0.01f) return e * (1.0f - e * (0.5f - e * (1.0f / 3.0f)));
    return __logf(1.0f + e);
}
__device__ __forceinline__ void unpack8(const u32x4 w, float (&f)[8]) {
    f[0] = bflo(w.x); f[1] = bfhi(w.x); f[2] = bflo(w.y); f[3] = bfhi(w.y); f[4] = bflo(w.z); f[5] = bfhi(w.z); f[6] = bflo(w.w); f[7] = bfhi(w.w);
}

struct Args { const float* in[25]; float* out; unsigned char* ws; int ph_lo, ph_hi, multi, pad; };
namespace pg8 {
#define PG8_LAS __attribute__((address_space(3)))
constexpr int BM = 256, BK = 64, HALF = 128, HTB = HALF * BK * 2  , STAGE_BYTES = 8 * HTB, NXCD = 8, WGM = 8;

__host__ __device__ __forceinline__ int lds_byte(int r, int c) { const int st = (r >> 4) * 2 + (c >> 5), rr = r & 15, cc = c & 31, ob = rr * 64 + cc * 2; return st * 1024 + (ob ^ (((ob >> 9) & 1) << 5)); }
__host__ __device__ __forceinline__ void stage_rc(int b, int& R, int& C) { const int st = b / 1024, sb = b % 1024, swz = sb ^ (((sb >> 9) & 1) << 5); R = (st >> 1) * 16 + swz / 64; C = (st & 1) * 32 + (swz % 64) / 2; }
__host__ __device__ __forceinline__ int perm32(int rho) { const int n = rho >> 4, i = rho & 15; return 8 * (i >> 2) + 4 * n + (i & 3); }

#ifndef EPI_SC1
#define EPI_SC1 0
#endif
__device__ __forceinline__ void st16(void* p, u32x4 w) {
#if EPI_SC1
    asm volatile("global_store_dwordx4 %0, %1, off sc1" :: "v"(p), "v"(w) : "memory");
#else
    *(u32x4*)p = w;
#endif
}
struct Unit { int pm, pn, pb; };
struct Gemm { const bf16_t* A; const bf16_t* Bt; int K; };

struct StaticOrder {
    int nM, nN, nwg, G, c, nbe;
    __host__ __device__ __forceinline__ void init(int M, int N, int G_, int c_, int nbe_) { nM = M / BM; nN = N / BM; nwg = nM * nN; G = G_; c = c_; nbe = nbe_; }
    __host__ __device__ __forceinline__ bool next(int i, Unit& u) const {
        const long L = (long)i * G + c; if (L >= nwg) return false;
        int wgid = (int)L; { const int q = nwg / NXCD, r = nwg % NXCD, xcd = wgid % NXCD, off = wgid / NXCD; wgid = (xcd < r ? xcd * (q + 1) : r * (q + 1) + (xcd - r) * q) + off; }
        const int nig = WGM * nN, gid = wgid / nig, fm = gid * WGM, gsz = (nM - fm) < WGM ? (nM - fm) : WGM;
        u.pm = fm + ((wgid % nig) % gsz); u.pn = (wgid % nig) / gsz; u.pb = nbe ? (u.pm >> 3) * nbe + u.pn : u.pn; return true;
    }
};

struct EpiU {
    static constexpr bool INIT = false;
    bf16_t* U; float* dtraw; const PG8_LAS float* rs;
    __device__ __forceinline__ void operator()(const f32x4 (&acc)[2][2][4][2], const Unit& u, int wr, int wc, int fr, int fq, int ui) const {
        const int row0 = u.pm * BM + wr * 64 + fr;
        if (u.pn == 19) {
            if (wc == 0 && fq < 2) {
#pragma unroll
                for (int ai = 0; ai < 2; ++ai)
#pragma unroll
                    for (int m = 0; m < 4; ++m) { const float rsv = rs[ui * BM + wr * 64 + fr + ai * HALF + m * 16]; float* p = dtraw + (size_t)(row0 + ai * HALF + m * 16) * 16 + 8 * fq; *(f32x4*)p = acc[ai][0][m][0] * rsv; *(f32x4*)(p + 4) = acc[ai][0][m][1] * rsv; }
            }
            return;
        }
        const int col0 = u.pn * BM + wc * 32 + 8 * fq;
#pragma unroll
        for (int ai = 0; ai < 2; ++ai)
#pragma unroll
            for (int m = 0; m < 4; ++m) { const float rsv = rs[ui * BM + wr * 64 + fr + ai * HALF + m * 16]; bf16_t* rowp = U + (size_t)(row0 + ai * HALF + m * 16) * NU + col0;
#pragma unroll
                for (int bj = 0; bj < 2; ++bj) { const f32x4 v0 = acc[ai][bj][m][0] * rsv, v1 = acc[ai][bj][m][1] * rsv;
                    u32x4 w; w.x = cvtpk(v0[0], v0[1]); w.y = cvtpk(v0[2], v0[3]); w.z = cvtpk(v1[0], v1[1]); w.w = cvtpk(v1[2], v1[3]);
                    st16(rowp + bj * HALF, w); } }
    }
};
struct EpiRes {
    static constexpr bool INIT = true;
    bf16_t* XR;
    __device__ __forceinline__ void init(f32x4 (&acc)[2][2][4][2], const Unit& u, int wr, int wc, int fr, int fq) const {
        const int row0 = u.pm * BM + wr * 64 + fr, col0 = u.pn * BM + wc * 32 + 8 * fq;
        u32x4 r[2][4][2];
#pragma unroll
        for (int ai = 0; ai < 2; ++ai)
#pragma unroll
            for (int m = 0; m < 4; ++m)
#pragma unroll
                for (int bj = 0; bj < 2; ++bj) r[ai][m][bj] = *(const u32x4*)(XR + (size_t)(row0 + ai * HALF + m * 16) * DM + col0 + bj * HALF);
#pragma unroll
        for (int ai = 0; ai < 2; ++ai)
#pragma unroll
            for (int m = 0; m < 4; ++m)
#pragma unroll
                for (int bj = 0; bj < 2; ++bj) { const u32x4 w = r[ai][m][bj]; acc[ai][bj][m][0] = (f32x4){bflo(w.x), bfhi(w.x), bflo(w.y), bfhi(w.y)}; acc[ai][bj][m][1] = (f32x4){bflo(w.z), bfhi(w.z), bflo(w.w), bfhi(w.w)}; }
    }
    __device__ __forceinline__ void operator()(const f32x4 (&acc)[2][2][4][2], const Unit& u, int wr, int wc, int fr, int fq, int ui) const {
        const int row0 = u.pm * BM + wr * 64 + fr, col0 = u.pn * BM + wc * 32 + 8 * fq;
        u32x4 r[2][4][2];
        if (ui != 0) {
#pragma unroll
            for (int ai = 0; ai < 2; ++ai)
#pragma unroll
                for (int m = 0; m < 4; ++m)
#pragma unroll
                    for (int bj = 0; bj < 2; ++bj) r[ai][m][bj] = *(const u32x4*)(XR + (size_t)(row0 + ai * HALF + m * 16) * DM + col0 + bj * HALF);
        }
#pragma unroll
        for (int ai = 0; ai < 2; ++ai)
#pragma unroll
            for (int m = 0; m < 4; ++m)
#pragma unroll
                for (int bj = 0; bj < 2; ++bj) { f32x4 v0 = acc[ai][bj][m][0], v1 = acc[ai][bj][m][1];
                    if (ui != 0) { const u32x4 w = r[ai][m][bj]; v0 += (f32x4){bflo(w.x), bfhi(w.x), bflo(w.y), bfhi(w.y)}; v1 += (f32x4){bflo(w.z), bfhi(w.z), bflo(w.w), bfhi(w.w)}; }
                    u32x4 o; o.x = cvtpk(v0[0], v0[1]); o.y = cvtpk(v0[2], v0[3]); o.z = cvtpk(v1[0], v1[1]); o.w = cvtpk(v1[2], v1[3]);
                    *(u32x4*)(XR + (size_t)(row0 + ai * HALF + m * 16) * DM + col0 + bj * HALF) = o; }
    }
};
struct EpiSwiglu {
    static constexpr bool INIT = false;
    bf16_t* H; const PG8_LAS float* rs;
    __device__ __forceinline__ void operator()(const f32x4 (&acc)[2][2][4][2], const Unit& u, int wr, int wc, int fr, int fq, int ui) const {
        const int row0 = u.pm * BM + wr * 64 + fr, col0 = u.pn * HALF + wc * 32 + 8 * fq;
#pragma unroll
        for (int ai = 0; ai < 2; ++ai)
#pragma unroll
            for (int m = 0; m < 4; ++m) { bf16_t* rowp = H + (size_t)(row0 + ai * HALF + m * 16) * FF + col0;
                const float rsv = rs[ui * BM + wr * 64 + fr + ai * HALF + m * 16];
                float h[8];
#pragma unroll
                for (int n = 0; n < 2; ++n)
#pragma unroll
                    for (int j = 0; j < 4; ++j) { const float g = acc[ai][0][m][n][j] * rsv, up = acc[ai][1][m][n][j] * rsv; h[n * 4 + j] = g * __builtin_amdgcn_rcpf(1.0f + __expf(-g)) * up; }
                u32x4 w; w.x = cvtpk(h[0], h[1]); w.y = cvtpk(h[2], h[3]); w.z = cvtpk(h[4], h[5]); w.w = cvtpk(h[6], h[7]);
                st16(rowp, w); }
    }
};
struct EpiDown {
    static constexpr bool INIT = false;
    bf16_t* Y; const float* gate;
    __device__ __forceinline__ void operator()(const f32x4 (&acc)[2][2][4][2], const Unit& u, int wr, int wc, int fr, int fq, int ui) const {
        const int row0 = u.pm * BM + wr * 64 + fr, col0 = u.pn * BM + wc * 32 + 8 * fq;
        float gtv[2][4];
#pragma unroll
        for (int ai = 0; ai < 2; ++ai)
#pragma unroll
            for (int m = 0; m < 4; ++m) gtv[ai][m] = gate[row0 + ai * HALF + m * 16];
#pragma unroll
        for (int ai = 0; ai < 2; ++ai)
#pragma unroll
            for (int m = 0; m < 4; ++m) { const int row = row0 + ai * HALF + m * 16; const float gt = gtv[ai][m]; bf16_t* rowp = Y + (size_t)row * DM + col0;
#pragma unroll
                for (int bj = 0; bj < 2; ++bj) { const f32x4 v0 = acc[ai][bj][m][0] * gt, v1 = acc[ai][bj][m][1] * gt;
                    u32x4 w; w.x = cvtpk(v0[0], v0[1]); w.y = cvtpk(v0[2], v0[3]); w.z = cvtpk(v1[0], v1[1]); w.w = cvtpk(v1[2], v1[3]);
                    st16(rowp + bj * HALF, w); } }
    }
};

template <class Epi, class Sched, bool GATHER, int BAUX = 0>
__device__ __forceinline__ void gemm_phase(PG8_LAS unsigned char* lds, const Gemm g, const Sched& S, const Epi& E, const PG8_LAS int* rmap) {
    int tid_ = threadIdx.x; asm volatile("" : "+v"(tid_));
    const int tid = tid_, wid = __builtin_amdgcn_readfirstlane(tid >> 6), lane = tid & 63, wr = wid >> 2, wc = wid & 3, fr = lane & 15, fq = lane >> 4;
    const int K = g.K, nt = K / BK;
    const size_t kstep = (size_t)(BK * 2);
    const size_t hstep = (size_t)HALF * K * 2;
    const size_t tstep = 2 * hstep;
    int RA[2], CA[2]; unsigned voffB[2], offA[2][2], offN[2][2];
#pragma unroll
    for (int i = 0; i < 2; ++i) { int R, C; stage_rc(tid * 16 + i * 8192, R, C); const int Rb = (R & ~31) + perm32(R & 31);
        RA[i] = R; CA[i] = C; voffB[i] = (unsigned)(Rb * K + C) * 2u;
        offA[0][i] = (unsigned)(R * K + C) * 2u; offA[1][i] = offA[0][i] + (unsigned)hstep; offN[0][i] = offA[0][i]; offN[1][i] = offA[1][i]; }
    const unsigned ldsw = (unsigned)wid * 1024u;
    const int aoff = lds_byte(wr * 64 + fr, fq * 8), boff = lds_byte(wc * 32 + fr, fq * 8);
#define PG8_SA(b, h) (((b) * 2 + (h)) * HTB)
#define PG8_SB(b, h) ((4 + (b) * 2 + (h)) * HTB)
#define PG8_STAGE(bufoff, gbase, voff) do { _Pragma("unroll") for (int _i = 0; _i < 2; ++_i) \
        __builtin_amdgcn_global_load_lds((const unsigned*)((const char*)(gbase) + (voff)[_i]), (PG8_LAS unsigned*)(lds + (bufoff) + ldsw + _i * 8192), 16, 0, 0); } while (0)
#define PG8_STAGEB(bufoff, gbase, voff) do { _Pragma("unroll") for (int _i = 0; _i < 2; ++_i) \
        __builtin_amdgcn_global_load_lds((const unsigned*)((const char*)(gbase) + (voff)[_i]), (PG8_LAS unsigned*)(lds + (bufoff) + ldsw + _i * 8192), 16, 0, BAUX); } while (0)
#define PG8_LDA(dst, b, h) do { _Pragma("unroll") for (int m = 0; m < 4; ++m) _Pragma("unroll") for (int k = 0; k < 2; ++k) dst[m][k] = *(const PG8_LAS bf16x8*)(lds + PG8_SA(b, h) + aoff + m * 2048 + k * 1024); } while (0)
#define PG8_LDB(dst, b, h) do { _Pragma("unroll") for (int n = 0; n < 2; ++n) _Pragma("unroll") for (int k = 0; k < 2; ++k) dst[n][k] = *(const PG8_LAS bf16x8*)(lds + PG8_SB(b, h) + boff + n * 2048 + k * 1024); } while (0)
#define PG8_MMA(ai, bj, At, Bt) do { __builtin_amdgcn_s_setprio(1); _Pragma("unroll") for (int m = 0; m < 4; ++m) _Pragma("unroll") for (int n = 0; n < 2; ++n) _Pragma("unroll") for (int k = 0; k < 2; ++k) \
        acc[ai][bj][m][n] = __builtin_amdgcn_mfma_f32_16x16x32_bf16(Bt[n][k], At[m][k], acc[ai][bj][m][n], 0, 0, 0); __builtin_amdgcn_s_setprio(0); } while (0)
#define PG8_WAIT_V(n) asm volatile("s_waitcnt vmcnt(" #n ")" ::: "memory")
#define PG8_WAIT_L(n) asm volatile("s_waitcnt lgkmcnt(" #n ")" ::: "memory")
#define PG8_BAR __builtin_amdgcn_s_barrier()
#define PG8_SCHED __builtin_amdgcn_sched_barrier(0)
    Unit cur, nxt; int ui = 0;
    if (!S.next(0, cur)) return;
    f32x4 acc[2][2][4][2];
    if constexpr (Epi::INIT) E.init(acc, cur, wr, wc, fr, fq);
    else {
#pragma unroll
    for (int a = 0; a < 2; ++a)
#pragma unroll
        for (int b = 0; b < 2; ++b)
#pragma unroll
            for (int m = 0; m < 4; ++m)
#pragma unroll
                for (int n = 0; n < 2; ++n) acc[a][b][m][n] = (f32x4){0.f, 0.f, 0.f, 0.f};
    }
    bf16x8 At[4][2], B0[2][2], B1[2][2];
    if constexpr (GATHER) {
#pragma unroll
        for (int h = 0; h < 2; ++h)
#pragma unroll
            for (int i = 0; i < 2; ++i) { offA[h][i] = (unsigned)(rmap[h * HALF + RA[i]] * K + CA[i]) * 2u; offN[h][i] = offA[h][i]; }
    }
    const char* cA = (const char*)g.A + (GATHER ? (size_t)0 : (size_t)cur.pm * tstep); const char* cB = (const char*)g.Bt + (size_t)cur.pb * tstep;
    PG8_STAGEB(PG8_SB(0, 0), cB, voffB); PG8_STAGEB(PG8_SB(0, 1), cB + hstep, voffB); PG8_STAGE(PG8_SA(0, 0), cA, offA[0]); PG8_STAGE(PG8_SA(0, 1), cA, offA[1]);
    if (wr == 1) PG8_BAR;
    PG8_WAIT_V(2); PG8_BAR;
    PG8_STAGEB(PG8_SB(1, 0), cB + kstep, voffB); PG8_STAGE(PG8_SA(1, 0), cA + kstep, offA[0]); PG8_STAGEB(PG8_SB(1, 1), cB + hstep + kstep, voffB);
    PG8_WAIT_V(6); PG8_BAR;
    for (;;) {
        const bool has_next = S.next(ui + 1, nxt);
        const char* nA = (has_next && !GATHER) ? (const char*)g.A + (size_t)nxt.pm * tstep : cA; const char* nB = has_next ? (const char*)g.Bt + (size_t)nxt.pb * tstep : cB;
        if constexpr (GATHER) {
            if (has_next) {
#pragma unroll
                for (int h = 0; h < 2; ++h)
#pragma unroll
                    for (int i = 0; i < 2; ++i) offN[h][i] = (unsigned)(rmap[(ui + 1) * BM + h * HALF + RA[i]] * K + CA[i]) * 2u;
            }
        }
        for (int t = 0; t < nt; t += 2) {
            const bool last = (t == nt - 2);
            const char* a1 = cA + (size_t)(t + 1) * kstep;
            const char* a2 = last ? nA : cA + (size_t)(t + 2) * kstep; const char* b2 = last ? nB : cB + (size_t)(t + 2) * kstep;
            const char* a3 = a2 + kstep; const char* b3 = b2 + kstep;
            unsigned o2[2][2];
#pragma unroll
            for (int h = 0; h < 2; ++h)
#pragma unroll
                for (int i = 0; i < 2; ++i) o2[h][i] = (GATHER && last) ? offN[h][i] : offA[h][i];
            PG8_LDB(B0, 0, 0); PG8_LDB(B1, 0, 1); PG8_SCHED; PG8_LDA(At, 0, 0); PG8_STAGE(PG8_SA(1, 1), a1, offA[1]);
            PG8_WAIT_V(8); PG8_WAIT_L(0); PG8_BAR; PG8_MMA(0, 0, At, B0); PG8_MMA(0, 1, At, B1); PG8_BAR; PG8_SCHED;
            PG8_LDA(At, 0, 1); PG8_STAGEB(PG8_SB(0, 0), b2, voffB); PG8_STAGEB(PG8_SB(0, 1), b2 + hstep, voffB); PG8_STAGE(PG8_SA(0, 0), a2, o2[0]);
            PG8_WAIT_V(8); PG8_WAIT_L(0); PG8_BAR; PG8_MMA(1, 0, At, B0); PG8_MMA(1, 1, At, B1); PG8_BAR; PG8_SCHED;
            PG8_LDB(B0, 1, 0); PG8_LDB(B1, 1, 1); PG8_SCHED; PG8_LDA(At, 1, 0); PG8_STAGE(PG8_SA(0, 1), a2, o2[1]);
            PG8_WAIT_V(8); PG8_WAIT_L(0); PG8_BAR; PG8_MMA(0, 0, At, B0); PG8_MMA(0, 1, At, B1); PG8_BAR; PG8_SCHED;
            PG8_LDA(At, 1, 1); PG8_STAGEB(PG8_SB(1, 0), b3, voffB); PG8_STAGEB(PG8_SB(1, 1), b3 + hstep, voffB); PG8_STAGE(PG8_SA(1, 0), a3, o2[0]);
            PG8_WAIT_V(8); PG8_WAIT_L(0); PG8_BAR; PG8_MMA(1, 0, At, B0); PG8_MMA(1, 1, At, B1); PG8_BAR; PG8_SCHED;
        }
        if (wr == 0) PG8_BAR;
        E(acc, cur, wr, wc, fr, fq, ui);
        if (!has_next) break;
#pragma unroll
        for (int a = 0; a < 2; ++a)
#pragma unroll
            for (int b = 0; b < 2; ++b)
#pragma unroll
                for (int m = 0; m < 4; ++m)
#pragma unroll
                    for (int n = 0; n < 2; ++n) acc[a][b][m][n] = (f32x4){0.f, 0.f, 0.f, 0.f};
        cur = nxt; cA = nA; cB = nB; ++ui;
        if constexpr (GATHER) {
#pragma unroll
            for (int h = 0; h < 2; ++h)
#pragma unroll
                for (int i = 0; i < 2; ++i) offA[h][i] = offN[h][i];
        }
        if (wr == 1) PG8_BAR;
    }
    PG8_WAIT_V(0);
    PG8_BAR;
#undef PG8_SA
#undef PG8_SB
#undef PG8_STAGE
#undef PG8_STAGEB
#undef PG8_LDA
#undef PG8_LDB
#undef PG8_MMA
#undef PG8_WAIT_V
#undef PG8_WAIT_L
#undef PG8_BAR
#undef PG8_SCHED
}
}
#define XB_TMO      128
#define XB_XCNT(j)  (256  + 64 * (j))
#define XB_XSUB(j)  (1280 + 64 * (j))
#define XB_XGEN(j)  (2304 + 64 * (j))
#define XB_TOP      3328
#define XB_TOPGEN   3392
#define XCD_BAR_WORDS 3456
#define XB_SPIN_CAP (1u << 18)
#ifndef EARLY_WB
#define EARLY_WB 0
#endif
#ifndef INV_L1_ONLY
#define INV_L1_ONLY 1
#endif

__device__ __forceinline__ unsigned xb_ld(unsigned* p)              { return __hip_atomic_load(p, __ATOMIC_RELAXED, __HIP_MEMORY_SCOPE_AGENT); }
__device__ __forceinline__ unsigned xb_add(unsigned* p, unsigned v) { return __hip_atomic_fetch_add(p, v, __ATOMIC_RELAXED, __HIP_MEMORY_SCOPE_AGENT); }
__device__ __forceinline__ unsigned xb_xcc_id() { return (unsigned)__builtin_amdgcn_s_getreg((3 << 11) | 20) & 0xFu; }
#define XB_SPIN(cond, bar) do { unsigned _sp = 0; while (cond) { __builtin_amdgcn_s_sleep(1); \
    if ((++_sp & 255u) == 0u) { if (xb_ld(&(bar)[XB_TMO])) break; if (_sp > XB_SPIN_CAP) { atomicAdd(&(bar)[XB_TMO], 1u); break; } } } } while (0)

struct XcdBarrier {
    unsigned* bar; unsigned x;
    volatile LAS unsigned* st;
};

__device__ __forceinline__ XcdBarrier xcd_barrier_post(unsigned* bar, volatile LAS unsigned* st) {
    XcdBarrier b; b.bar = bar; b.x = xb_xcc_id(); b.st = st;
    if (threadIdx.x == 0) (void)xb_add(&bar[XB_XCNT(b.x)], 1u);
    return b;
}
__device__ __forceinline__ void xcd_barrier_complete(unsigned* bar, unsigned x, unsigned& nloc, unsigned& nx) {
    const unsigned G = gridDim.x * gridDim.y * gridDim.z;
    unsigned sum, cnt, mine, sp = 0u;
    for (;;) {
        sum = 0u; cnt = 0u; mine = 0u;
#pragma unroll
        for (unsigned j = 0; j < 16; ++j) { const unsigned c = xb_ld(&bar[XB_XCNT(j)]); sum += c; cnt += (c > 0u) ? 1u : 0u; mine = (j == x) ? c : mine; }
        if (sum == G) break;
        __builtin_amdgcn_s_sleep(1);
        if ((++sp & 255u) == 0u) { if (xb_ld(&bar[XB_TMO])) break; if (sp > XB_SPIN_CAP) { atomicAdd(&bar[XB_TMO], 1u); break; } }
    }
    nloc = mine > 0u ? mine : 1u; nx = cnt > 0u ? cnt : 1u;
}

__device__ __forceinline__ void xcd_barrier_census_wave(const XcdBarrier& b, int lane) {
    const unsigned G = gridDim.x * gridDim.y * gridDim.z; unsigned* bar = b.bar;
    unsigned c, sum, sp = 0u;
    for (;;) {
        c = lane < 16 ? xb_ld(&bar[XB_XCNT(lane & 15)]) : 0u;
        sum = c;
#pragma unroll
        for (int o = 1; o < 16; o <<= 1) sum += (unsigned)__builtin_amdgcn_ds_bpermute((lane ^ o) << 2, (int)sum);
        sum = (unsigned)__builtin_amdgcn_readfirstlane((int)sum);
        if (sum == G) break;
        __builtin_amdgcn_s_sleep(1);
        if ((++sp & 255u) == 0u) { if (xb_ld(&bar[XB_TMO])) break; if (sp > XB_SPIN_CAP) { if (lane == 0) atomicAdd(&bar[XB_TMO], 1u); break; } }
    }
    const unsigned cnt = (unsigned)__builtin_popcountll(__ballot(c > 0u));
    const unsigned mine = (unsigned)__builtin_amdgcn_readlane((int)c, (int)(b.x & 15u));
    if (lane == 0) { b.st[0] = mine > 0u ? mine : 1u; b.st[1] = cnt > 0u ? cnt : 1u; }
}

__device__ __forceinline__ void xcd_barrier(const XcdBarrier& b) {
    asm volatile("s_waitcnt vmcnt(0)" ::: "memory");
    __syncthreads();
    if (threadIdx.x == 0) {
        unsigned* bar = b.bar;
        __builtin_amdgcn_s_waitcnt(0);
        unsigned nloc = b.st[0], nx = b.st[1];
        if (nloc == 0u) { xcd_barrier_complete(bar, b.x, nloc, nx); b.st[0] = nloc; b.st[1] = nx; }
        const unsigned old = xb_add(&bar[XB_XSUB(b.x)], 1u);
        const unsigned gen = old / nloc;
        if (old + 1u == (gen + 1u) * nloc) {
            __builtin_amdgcn_fence(__ATOMIC_RELEASE, "agent");
            asm volatile("s_waitcnt vmcnt(0)" ::: "memory");
            const unsigned og = xb_add(&bar[XB_TOP], 1u);
            const unsigned tg = og / nx;
            if (og + 1u == (tg + 1u) * nx) xb_add(&bar[XB_TOPGEN], 1u);
            else XB_SPIN(xb_ld(&bar[XB_TOPGEN]) == tg, bar);
            __builtin_amdgcn_fence(__ATOMIC_ACQUIRE, "agent");
#if INV_L1_ONLY
            asm volatile("s_waitcnt vmcnt(0)" ::: "memory");
#endif
            xb_add(&bar[XB_XGEN(b.x)], 1u);
            asm volatile("s_waitcnt vmcnt(0)" ::: "memory");
        } else {
#if EARLY_WB
            asm volatile("buffer_wbl2 sc1" ::: "memory");
#endif
            XB_SPIN(xb_ld(&bar[XB_XGEN(b.x)]) == gen, bar);
#if INV_L1_ONLY
            asm volatile("s_waitcnt vmcnt(0)\n\tbuffer_inv sc0" ::: "memory");
#else
            __builtin_amdgcn_fence(__ATOMIC_ACQUIRE, "agent");
#endif
            asm volatile("s_waitcnt vmcnt(0)" ::: "memory");
        }
    }
    __syncthreads();
}

__device__ __forceinline__ void wg_arrive(unsigned* ctr) {
    asm volatile("s_waitcnt vmcnt(0)" ::: "memory");
    __syncthreads();
    if (threadIdx.x == 0) {
        __builtin_amdgcn_fence(__ATOMIC_RELEASE, "agent");
        asm volatile("s_waitcnt vmcnt(0)" ::: "memory");
        (void)xb_add(ctr, 1u);
    }
}
__device__ __forceinline__ void wg_wait(unsigned* ctr, unsigned target, unsigned* tmo) {
    if (threadIdx.x == 0) {
        unsigned sp = 0u;
        while (xb_ld(ctr) < target) { __builtin_amdgcn_s_sleep(1); if ((++sp & 255u) == 0u) { if (xb_ld(tmo)) break; if (sp > XB_SPIN_CAP) { atomicAdd(tmo, 1u); break; } } }
        __builtin_amdgcn_fence(__ATOMIC_ACQUIRE, "agent");
        asm volatile("s_waitcnt vmcnt(0)" ::: "memory");
    }
    __syncthreads();
}
struct Ctx { LAS unsigned char* lds; int tid, lane, wave, G, bid, gw, NGW; };
#define LDS_WAIT() asm volatile("s_waitcnt lgkmcnt(0)" ::: "memory")

#ifndef LAZY_CONVERT
#define LAZY_CONVERT 1
#endif
#ifndef JIT_CONVERT
#define JIT_CONVERT 1
#endif
struct TItem { const float* src; bf16_t* dst; const float* ksc; int ldw, nv, ldk; f32x4 k0, k1; };
__device__ __forceinline__ TItem prologue_item(const Args& a, int it) {
    constexpr int I_IN = 32 * 160, I_OUT = 32 * 64, I_GU = 16 * 32 * 64, I_DN = 16 * 16 * 64, I_L = I_IN + I_OUT + I_GU + I_DN;
    bf16_t* WIN = (bf16_t*)(a.ws + WS_WIN); bf16_t* WOUT = (bf16_t*)(a.ws + WS_WOUT); bf16_t* WGU = (bf16_t*)(a.ws + WS_WGU); bf16_t* WDN = (bf16_t*)(a.ws + WS_WDN);
    const int l = it / I_L; int r = it % I_L; TItem t; t.ksc = nullptr;
    if (r < I_IN) { const int kb = r / 160, nb = r % 160, k0 = 64 * kb, n0 = 32 * nb; int s0, nv;
        if (n0 < 3840) { s0 = n0; nv = 32; } else if (n0 < 4864) { s0 = n0 + 16; nv = 32; } else if (n0 == 4864) { s0 = 3840; nv = 16; } else { s0 = 0; nv = 0; }
        t.ksc = a.in[1] + (size_t)l * DM + k0;
        t.src = a.in[2] + (size_t)l * DM * INW + (size_t)k0 * INW + s0; t.ldw = INW; t.nv = nv; t.dst = WIN + (size_t)l * NU * DM + (size_t)n0 * DM + k0; t.ldk = DM; return t; }
    r -= I_IN;
    if (r < I_OUT) { const int kb = r / 64, nb = r % 64, k0 = 64 * kb, n0 = 32 * nb;
        t.src = a.in[19] + (size_t)l * DM * DM + (size_t)k0 * DM + n0; t.ldw = DM; t.nv = 32; t.dst = WOUT + (size_t)l * DM * DM + (size_t)n0 * DM + k0; t.ldk = DM; return t; }
    r -= I_OUT;
    if (r < I_GU) { const int e = r / 2048, rr = r % 2048, kb = rr / 64, nb = rr % 64, k0 = 64 * kb, n0 = 32 * nb, pn = n0 >> 8, rt = n0 & 255;
        const float* W = (rt < 128 ? a.in[22] : a.in[23]) + (size_t)(l * NEXP + e) * DM * FF; const int s0 = 128 * pn + (rt & 127);
        t.ksc = a.in[20] + (size_t)l * DM + k0;
        t.src = W + (size_t)k0 * FF + s0; t.ldw = FF; t.nv = 32; t.dst = WGU + ((size_t)(l * NEXP + e) * 2048 + n0) * DM + k0; t.ldk = DM; return t; }
    r -= I_GU;
    { const int e = r / 1024, rr = r % 1024, kb = rr / 64, nb = rr % 64, k0 = 64 * kb, n0 = 32 * nb;
        t.src = a.in[24] + (size_t)(l * NEXP + e) * FF * DM + (size_t)k0 * DM + n0; t.ldw = DM; t.nv = 32; t.dst = WDN + ((size_t)(l * NEXP + e) * 2048 + n0) * FF + k0; t.ldk = FF; return t; }
}
__device__ __forceinline__ void titem_load(TItem& t, f32x4 (&v)[8], int lane) {
    const int q = lane & 7, rr = lane >> 3;
    t.k0 = (f32x4){1.f, 1.f, 1.f, 1.f}; t.k1 = t.k0;
    if (t.ksc) { t.k0 = *(const f32x4*)(t.ksc + 8 * (lane & 7)); t.k1 = *(const f32x4*)(t.ksc + 8 * (lane & 7) + 4); }
#pragma unroll
    for (int i = 0; i < 8; ++i) { v[i] = (f32x4){0.f, 0.f, 0.f, 0.f}; if (4 * q < t.nv) v[i] = *(const f32x4*)(t.src + (size_t)(8 * i + rr) * t.ldw + 4 * q); }
}
__device__ __forceinline__ void titem_store(const TItem& t, const f32x4 (&v)[8], LAS float* scr, int lane) {
    const int q = lane & 7, rr = lane >> 3;
#pragma unroll
    for (int i = 0; i < 8; ++i) { LAS float* s = scr + (8 * i + rr) * 33 + 4 * q; s[0] = v[i][0]; s[1] = v[i][1]; s[2] = v[i][2]; s[3] = v[i][3]; }
    LDS_WAIT();
    const int c = lane & 7;
    const f32x4 k0 = t.k0, k1 = t.k1;
#pragma unroll
    for (int j = 0; j < 4; ++j) { const int n = (lane >> 3) + 8 * j; const LAS float* s = scr + (8 * c) * 33 + n;
        u32x4 o; o.x = cvtpk(s[0 * 33] * k0[0], s[1 * 33] * k0[1]); o.y = cvtpk(s[2 * 33] * k0[2], s[3 * 33] * k0[3]); o.z = cvtpk(s[4 * 33] * k1[0], s[5 * 33] * k1[1]); o.w = cvtpk(s[6 * 33] * k1[2], s[7 * 33] * k1[3]);
        __builtin_nontemporal_store(o, (u32x4*)(t.dst + (size_t)n * t.ldk + 8 * c)); }
    LDS_WAIT();
}
__device__ __forceinline__ void convert_items(const Args& a, const Ctx& X, int first, int count) {
    LAS float* scr = (LAS float*)(X.lds + X.wave * 16384);
    const int n_it = (count - X.gw + X.NGW - 1) / X.NGW;
    if (n_it <= 0) return;
    TItem t0, t1, t2, t3; f32x4 v0[8], v1[8], v2[8], v3[8];
    t0 = prologue_item(a, first + X.gw); titem_load(t0, v0, X.lane);
    t1 = t0; t2 = t0; t3 = t0;
    if (n_it > 1) { t1 = prologue_item(a, first + X.gw + X.NGW); titem_load(t1, v1, X.lane); }
    if (n_it > 2) { t2 = prologue_item(a, first + X.gw + 2 * X.NGW); titem_load(t2, v2, X.lane); }
#pragma unroll 1
    for (int i = 0; i < n_it; i += 4) {
        if (i + 3 < n_it) { t3 = prologue_item(a, first + X.gw + (i + 3) * X.NGW); titem_load(t3, v3, X.lane); }
        titem_store(t0, v0, scr, X.lane);
        if (i + 1 >= n_it) break;
        if (i + 4 < n_it) { t0 = prologue_item(a, first + X.gw + (i + 4) * X.NGW); titem_load(t0, v0, X.lane); }
        titem_store(t1, v1, scr, X.lane);
        if (i + 2 >= n_it) break;
        if (i + 5 < n_it) { t1 = prologue_item(a, first + X.gw + (i + 5) * X.NGW); titem_load(t1, v1, X.lane); }
        titem_store(t2, v2, scr, X.lane);
        if (i + 3 >= n_it) break;
        if (i + 6 < n_it) { t2 = prologue_item(a, first + X.gw + (i + 6) * X.NGW); titem_load(t2, v2, X.lane); }
        titem_store(t3, v3, scr, X.lane);
    }
}
constexpr int CV_IN = 32 * 160, CV_IL = 32 * 160 + 32 * 64 + 16 * 32 * 64 + 16 * 16 * 64;
__device__ __forceinline__ void convert_layer_weights(const Args& a, const Ctx& X, int l) { convert_items(a, X, l * CV_IL, CV_IL); }
#ifndef TOPK_CONV
#define TOPK_CONV 1
#endif
constexpr int CV_TK = TOPK_CONV ? 2 * 8 * (256 - NB * NEXP) : 0;
__device__ __forceinline__ bool topk_conv_on(const Ctx& X) { return TOPK_CONV && X.G == 256; }
__device__ __forceinline__ void convert_jit(const Args& a, const Ctx& X, int l) { const int skip = (l > 0 && topk_conv_on(X)) ? CV_TK : 0;
    convert_items(a, X, l * CV_IL + CV_IN + skip, ((l + 1 < DEPTH) ? CV_IL : CV_IL - CV_IN) - skip); }
__device__ __forceinline__ void convert_in_topk(const Args& a, const Ctx& X, int l) {
    if (!topk_conv_on(X) || X.bid < NB * NEXP) return;
    Ctx Xc = X; Xc.bid -= NB * NEXP; Xc.G -= NB * NEXP; Xc.gw = Xc.bid * 8 + Xc.wave; Xc.NGW = Xc.G * 8;
    convert_items(a, Xc, (l + 1) * CV_IL + CV_IN, CV_TK); }
__device__ __forceinline__ void phase_prologue(const Args& a, const Ctx& X) {
#if LAZY_CONVERT && JIT_CONVERT
    convert_items(a, X, 0, CV_IN);
#elif LAZY_CONVERT
    convert_layer_weights(a, X, 0);
#else
    for (int l = 0; l < DEPTH; ++l) convert_layer_weights(a, X, l);
#endif
    { unsigned short* RTW = (unsigned short*)(a.ws + WS_RTW);
      for (int i = X.bid * 512 + X.tid; i < DEPTH * DM * NEXP; i += X.G * 512) { const int l = i / (DM * NEXP), r = i % (DM * NEXP), k = r >> 4, e = r & 15;
          const float w = a.in[21][i] * a.in[20][l * DM + k];
          const unsigned hi = cvtpk(w, 0.f) & 0xffffu; const unsigned lo = cvtpk(w - __uint_as_float(hi << 16), 0.f) & 0xffffu;
          RTW[((size_t)(l * 2 + 0) * NEXP + e) * DM + k] = (unsigned short)hi; RTW[((size_t)(l * 2 + 1) * NEXP + e) * DM + k] = (unsigned short)lo; } }
    float* rope = (float*)(a.ws + WS_ROPE);
    for (int i = X.bid * 512 + X.tid; i < SEQ * 8; i += X.G * 512) { const int pos = i >> 3, k = i & 7;
        const double ivf = k == 0 ? 0.15915494309189535 : k == 1 ? 0.03086376340470123 : k == 2 ? 0.0059851857127137054 : k == 3 ? 0.001160663641240061 : k == 4 ? 0.00022507907903927653 : k == 5 ? 4.3647952792802891e-05 : k == 6 ? 8.4643308082414014e-06 : 1.6414262627950345e-06;
        const double rev = (double)pos * ivf; const float fr = (float)(rev - __builtin_floor(rev));
        rope[pos * 16 + k] = __builtin_amdgcn_cosf(fr); rope[pos * 16 + 8 + k] = __builtin_amdgcn_sinf(fr); }
}

__device__ __forceinline__ void phase_pre(const Args& a, const Ctx& X, int l, bool dummy = false) {
    bf16_t* XR = (bf16_t*)(a.ws + WS_XR);
    const int* sel = (const int*)(a.ws + WS_SEL); const bf16_t* Y = (const bf16_t*)(a.ws + WS_Y);
    bf16_t* XW = dummy ? (bf16_t*)(a.ws + WS_U) : XR; float* RS1 = (float*)(a.ws + (dummy ? WS_MIX : WS_RSTD1));
    for (int m = X.gw; m < T; m += X.NGW) {
        float v[4][8];
        int myslot = -1;
        if (l > 0 && X.lane < 16) myslot = sel[m * 16 + X.lane];
        if (l == 0) {
#pragma unroll
            for (int j = 0; j < 4; ++j) { const f32x4 a0 = *(const f32x4*)(a.in[0] + (size_t)m * DM + 8 * X.lane + 512 * j), a1 = *(const f32x4*)(a.in[0] + (size_t)m * DM + 8 * X.lane + 512 * j + 4);
                v[j][0] = a0[0]; v[j][1] = a0[1]; v[j][2] = a0[2]; v[j][3] = a0[3]; v[j][4] = a1[0]; v[j][5] = a1[1]; v[j][6] = a1[2]; v[j][7] = a1[3]; }
        } else {
            u32x4 xw[4];
#pragma unroll
            for (int j = 0; j < 4; ++j) xw[j] = *(const u32x4*)(XR + (size_t)m * DM + 8 * X.lane + 512 * j);
#pragma unroll
            for (int j = 0; j < 4; ++j) unpack8(xw[j], v[j]);
            unsigned long long mask = __ballot(myslot >= 0);
            while (mask) {
                int s4[4];
#pragma unroll
                for (int q = 0; q < 4; ++q) { s4[q] = -1; if (mask) { const int e = __builtin_ctzll(mask); mask &= mask - 1; s4[q] = shl_i(myslot, e); } }
                u32x4 w[4][4];
#pragma unroll
                for (int q = 0; q < 4; ++q) { const bf16_t* yr = Y + (size_t)(s4[q] < 0 ? 0 : s4[q]) * DM + 8 * X.lane;
#pragma unroll
                    for (int j = 0; j < 4; ++j) { w[q][j] = (u32x4){0u, 0u, 0u, 0u}; if (s4[q] >= 0) w[q][j] = *(const u32x4*)(yr + 512 * j); } }
#pragma unroll
                for (int q = 0; q < 4; ++q)
#pragma unroll
                    for (int j = 0; j < 4; ++j) { float f[8]; unpack8(w[q][j], f);
#pragma unroll
                        for (int e = 0; e < 8; ++e) v[j][e] += f[e]; }
            }
        }
        if (l < DEPTH) {
            float ss = 0.f;
#pragma unroll
            for (int j = 0; j < 4; ++j) { u32x4 o; o.x = cvtpk(v[j][0], v[j][1]); o.y = cvtpk(v[j][2], v[j][3]); o.z = cvtpk(v[j][4], v[j][5]); o.w = cvtpk(v[j][6], v[j][7]);
                *(u32x4*)(XW + (size_t)m * DM + 8 * X.lane + 512 * j) = o;
#pragma unroll
                for (int e = 0; e < 8; ++e) ss += v[j][e] * v[j][e]; }
            const float rstd = rsqrtf(wsum(ss) * (1.f / DM) + EPS);
            if (X.lane == 0) RS1[m] = rstd;
        } else {
#pragma unroll
            for (int j = 0; j < 4; ++j) { float* o = a.out + (size_t)m * DM + 8 * X.lane + 512 * j; *(f32x4*)o = (f32x4){v[j][0], v[j][1], v[j][2], v[j][3]}; *(f32x4*)(o + 4) = (f32x4){v[j][4], v[j][5], v[j][6], v[j][7]}; }
        }
    }
}

__device__ __forceinline__ void phase_router(const Args& a, const Ctx& X, int l) {
    LAS float* WR = (LAS float*)X.lds;
    const float* wr = a.in[21] + (size_t)l * DM * NEXP; const float* nw = a.in[20] + (size_t)l * DM;
    for (int i = X.tid; i < DM * NEXP; i += 512) { const int k = i >> 4, e = i & 15; WR[e * DM + (k >> 9) * 512 + ((k >> 2) & 1) * 256 + ((k & 511) >> 3) * 4 + (k & 3)] = wr[i] * nw[k]; }
    __syncthreads();
    float* AFF = (float*)(a.ws + WS_AFF); const bf16_t* XR = (const bf16_t*)(a.ws + WS_XR); float* RSTD = (float*)(a.ws + WS_RSTD);
    for (int m0 = 4 * X.gw; m0 < T; m0 += 4 * X.NGW) {
        float v[4][4][8];
        {
            u32x4 xw[4][4];
#pragma unroll
            for (int r = 0; r < 4; ++r)
#pragma unroll
                for (int j = 0; j < 4; ++j) xw[r][j] = *(const u32x4*)(XR + (size_t)(m0 + r) * DM + 8 * X.lane + 512 * j);
#pragma unroll
            for (int r = 0; r < 4; ++r)
#pragma unroll
                for (int j = 0; j < 4; ++j) unpack8(xw[r][j], v[r][j]);
        }
        float rstd[4];
#pragma unroll
        for (int r = 0; r < 4; ++r) { float ss = 0.f;
#pragma unroll
            for (int j = 0; j < 4; ++j)
#pragma unroll
                for (int e = 0; e < 8; ++e) ss += v[r][j][e] * v[r][j][e];
            rstd[r] = rsqrtf(wsum(ss) * (1.f / DM) + EPS);
            if (X.lane == 0) RSTD[m0 + r] = rstd[r]; }
        float mine[4] = {-INFINITY, -INFINITY, -INFINITY, -INFINITY};
#pragma unroll 1
        for (int e = 0; e < 16; ++e) { float acc[4] = {0.f, 0.f, 0.f, 0.f};
#pragma unroll
            for (int j = 0; j < 4; ++j)
#pragma unroll
                for (int hf = 0; hf < 2; ++hf) { const f32x4 w = *(const LAS f32x4*)(WR + e * DM + j * 512 + hf * 256 + 4 * X.lane);
#pragma unroll
                    for (int r = 0; r < 4; ++r) acc[r] += (v[r][j][4 * hf] * w[0] + v[r][j][4 * hf + 1] * w[1]) + (v[r][j][4 * hf + 2] * w[2] + v[r][j][4 * hf + 3] * w[3]); }
#pragma unroll
            for (int r = 0; r < 4; ++r) { const float t = wsum(acc[r]) * rstd[r]; mine[r] = (X.lane == e) ? t : mine[r]; } }
#pragma unroll
        for (int r = 0; r < 4; ++r) { float mx = mine[r];
#pragma unroll
            for (int o = 1; o < 16; o <<= 1) mx = fmaxf(mx, shx(mx, o));
            float pr = (X.lane < 16) ? __expf(mine[r] - mx) : 0.f; float sum = pr;
#pragma unroll
            for (int o = 1; o < 16; o <<= 1) sum += shx(sum, o);
            const int m = m0 + r;
            if (X.lane < 16) AFF[(size_t)((m >> 13) * 16 + X.lane) * SEQ + (m & 8191)] = pr / sum; }
    }
    __syncthreads();
}

constexpr int RT_PITCH = DM * 2 + 16;
constexpr int RT_CMB = 32 * RT_PITCH, RT_RS = RT_CMB + 4 * 64 * 5 * 4;
static_assert(RT_RS + 4 * 16 * 4 <= LDSCTL_OFF, "router LDS map");
__device__ __forceinline__ void phase_router_mfma(const Args& a, const Ctx& X, int l) {
    const bf16_t* XR = (const bf16_t*)(a.ws + WS_XR); float* AFF = (float*)(a.ws + WS_AFF); float* RSTD = (float*)(a.ws + WS_RSTD);
    const int fr = X.lane & 15, fq = X.lane >> 4, tile = X.wave & 3, kh = X.wave >> 2;
    constexpr int NRB = T / 64;
    int rb = X.bid;
    bf16x8 af[32];
    if (rb < NRB) { const bf16_t* xp = XR + (size_t)(rb * 64 + tile * 16 + fr) * DM + kh * 1024 + fq * 8;
#pragma unroll
        for (int s = 0; s < 32; ++s) af[s] = *(const bf16x8*)(xp + s * 32); }
    { const char* RTW = (const char*)(a.ws + WS_RTW) + (size_t)l * 2 * NEXP * DM * 2;
#pragma unroll
      for (int h = 0; h < 2; ++h) { u32x4 tw[8];
#pragma unroll
          for (int i = 0; i < 8; ++i) tw[i] = *(const u32x4*)(RTW + (size_t)(X.tid + 512 * (8 * h + i)) * 16);
#pragma unroll
          for (int i = 0; i < 8; ++i) { const int c = X.tid + 512 * (8 * h + i); *(LAS u32x4*)(X.lds + (c >> 8) * RT_PITCH + (c & 255) * 16) = tw[i]; } } }
    __syncthreads();
    LAS float* cmb = (LAS float*)(X.lds + RT_CMB) + (tile * 64 + X.lane) * 5; LAS float* rs = (LAS float*)(X.lds + RT_RS) + tile * 16;
#pragma unroll 1
    for (; rb < NRB; rb += X.G) {
        const int m0 = rb * 64 + tile * 16;
        f32x4 acc = (f32x4){0.f, 0.f, 0.f, 0.f}; float ss = 0.f;
        const LAS unsigned char* tb = X.lds + fr * RT_PITCH + (kh * 1024 + fq * 8) * 2;
#pragma unroll
        for (int s = 0; s < 32; ++s) { const bf16x8 bh = *(const LAS bf16x8*)(tb + s * 64), bl = *(const LAS bf16x8*)(tb + 16 * RT_PITCH + s * 64);
            acc = __builtin_amdgcn_mfma_f32_16x16x32_bf16(af[s], bh, acc, 0, 0, 0); acc = __builtin_amdgcn_mfma_f32_16x16x32_bf16(af[s], bl, acc, 0, 0, 0);
            float t[8]; unpack8(__builtin_bit_cast(u32x4, af[s]), t);
#pragma unroll
            for (int j = 0; j < 8; ++j) ss += t[j] * t[j]; }
        ss += shx(ss, 16); ss += shx(ss, 32);
        if (kh == 1) { cmb[0] = acc[0]; cmb[1] = acc[1]; cmb[2] = acc[2]; cmb[3] = acc[3]; cmb[4] = ss; }
        __syncthreads();
        if (kh == 0) {
            acc[0] += cmb[0]; acc[1] += cmb[1]; acc[2] += cmb[2]; acc[3] += cmb[3]; ss += cmb[4];
            const float rstd = rsqrtf(ss * (1.f / DM) + EPS);
            if (fq == 0) { RSTD[m0 + fr] = rstd; rs[fr] = rstd; }
            LDS_WAIT();
            f32x4 pr;
#pragma unroll
            for (int r = 0; r < 4; ++r) { const float lg = acc[r] * rs[4 * fq + r];
                float mx = lg;
#pragma unroll
                for (int o = 1; o < 16; o <<= 1) mx = fmaxf(mx, shx(mx, o));
                const float p = __expf(lg - mx); float sum = p;
#pragma unroll
                for (int o = 1; o < 16; o <<= 1) sum += shx(sum, o);
                pr[r] = p / sum; }
            const int mq = m0 + 4 * fq;
            *(f32x4*)(AFF + (size_t)((mq >> 13) * 16 + fr) * SEQ + (mq & 8191)) = pr;
        }
        if (rb + X.G < NRB) { const bf16_t* xp = XR + (size_t)((rb + X.G) * 64 + tile * 16 + fr) * DM + kh * 1024 + fq * 8;
#pragma unroll
            for (int s = 0; s < 32; ++s) af[s] = *(const bf16x8*)(xp + s * 32); }
        __syncthreads();
    }
}

__device__ __forceinline__ void topk_run(const Args& a, const Ctx& X, int be, bool publish, LAS int* rl, int ntab, int slot_base) {
    LAS unsigned* keys = (LAS unsigned*)X.lds; LAS unsigned* hist = keys + 8192; LAS unsigned* suf = hist + 256; LAS unsigned* ctl = suf + 256; LAS unsigned* wtot = ctl + 16;
    const int b = be >> 4, e = be & 15;
    const unsigned* src = (const unsigned*)(a.ws + WS_AFF) + (size_t)be * SEQ;
    { unsigned kv[16];
#pragma unroll
      for (int j = 0; j < 16; ++j) kv[j] = src[X.tid + 512 * j];
#pragma unroll
      for (int j = 0; j < 16; ++j) keys[X.tid + 512 * j] = kv[j]; }
    __syncthreads();
    unsigned prefix = 0u, mask = 0u, need = CAP;
    for (int pass = 0; pass < 4; ++pass) {
        const int shift = 24 - 8 * pass;
        if (X.tid < 256) hist[X.tid] = 0u;
        __syncthreads();
        for (int i = X.tid; i < SEQ; i += 512) { const unsigned k = keys[i]; if ((k & mask) == prefix) __hip_atomic_fetch_add(&hist[(k >> shift) & 255u], 1u, __ATOMIC_RELAXED, __HIP_MEMORY_SCOPE_WORKGROUP); }
        __syncthreads();
        if (X.wave == 0) {
            const u32x4 hv = *(const LAS u32x4*)(hist + 4 * X.lane);
            const unsigned own = hv.x + hv.y + hv.z + hv.w;
            unsigned incl = own;
#pragma unroll
            for (int o = 1; o < 64; o <<= 1) { const unsigned t = (unsigned)shdn_i((int)incl, o); if (X.lane + o < 64) incl += t; }
            const unsigned above = incl - own;
            const unsigned s3 = above + hv.w, s2 = s3 + hv.z, s1 = s2 + hv.y, s0 = s1 + hv.x;
            if (s3 >= need && above < need) { ctl[0] = 4 * X.lane + 3; ctl[1] = need - above; }
            else if (s2 >= need && s3 < need) { ctl[0] = 4 * X.lane + 2; ctl[1] = need - s3; }
            else if (s1 >= need && s2 < need) { ctl[0] = 4 * X.lane + 1; ctl[1] = need - s2; }
            else if (s0 >= need && s1 < need) { ctl[0] = 4 * X.lane; ctl[1] = need - s1; }
        }
        __syncthreads();
        prefix |= ctl[0] << shift; mask |= 0xffu << shift; need = ctl[1];
        __syncthreads();
    }
    const unsigned tk = prefix;
    unsigned k[16];
#pragma unroll
    for (int j = 0; j < 4; ++j) { const u32x4 w = *(const LAS u32x4*)(keys + X.tid * 16 + 4 * j); k[4 * j] = w.x; k[4 * j + 1] = w.y; k[4 * j + 2] = w.z; k[4 * j + 3] = w.w; }
    unsigned cnt = 0u;
#pragma unroll
    for (int j = 0; j < 16; ++j) cnt += (k[j] > tk ? 1u : 0u) + (k[j] == tk ? 0x10000u : 0u);
    unsigned v = cnt;
#pragma unroll
    for (int o = 1; o < 64; o <<= 1) { const unsigned t = (unsigned)shup_i((int)v, o); if (X.lane >= o) v += t; }
    if (X.lane == 63) wtot[X.wave] = v;
    __syncthreads();
    unsigned base = 0u, total = 0u;
#pragma unroll
    for (int w = 0; w < 8; ++w) { const unsigned t = wtot[w]; total += t; if (w < X.wave) base += t; }
    unsigned ex = base + v - cnt; unsigned gtb = ex & 0xffffu, eqb = ex >> 16; const unsigned ngt = total & 0xffffu;
    int* SEL = (int*)(a.ws + WS_SEL); int* RMAP = (int*)(a.ws + WS_RMAP); float* GATE = (float*)(a.ws + WS_GATE);
#pragma unroll
    for (int j = 0; j < 16; ++j) { const int tok = b * SEQ + X.tid * 16 + j; int slot = -1;
        if (k[j] > tk) { slot = (int)gtb; ++gtb; } else if (k[j] == tk) { if (eqb < need) slot = (int)(ngt + eqb); ++eqb; }
        const int row = e * 2048 + b * 1024 + slot;
        if (publish) { SEL[tok * 16 + e] = slot >= 0 ? row : -1; if (slot >= 0) { RMAP[row] = tok; GATE[row] = __uint_as_float(k[j]); } }
        if (rl && slot >= slot_base && slot < slot_base + 256) { rl[slot - slot_base] = tok; if (ntab > 1) rl[256 + slot - slot_base] = tok; } }
    __syncthreads();
}
__device__ __forceinline__ void phase_topk(const Args& a, const Ctx& X) {
    if (X.bid >= NB * NEXP) return;
    topk_run(a, X, X.bid, true, nullptr, 0, 0);
}

__device__ __forceinline__ void phase_ssd_prep(const Args& a, const Ctx& X, int l) {
    const bf16_t* U = (const bf16_t*)(a.ws + WS_U); float* XB = (float*)(a.ws + WS_XBC);
    const float* cw = a.in[9] + (size_t)l * 5 * 1024; const float* cb = a.in[10] + (size_t)l * 1024;
    for (int it = X.bid * 512 + X.tid; it < T * 128; it += X.G * 512) {
        const int m = it >> 7, c = (it & 127) * 8, t = m & 8191;
        float acc[8]; { const f32x4 b0 = *(const f32x4*)(cb + c), b1 = *(const f32x4*)(cb + c + 4); acc[0] = b0[0]; acc[1] = b0[1]; acc[2] = b0[2]; acc[3] = b0[3]; acc[4] = b1[0]; acc[5] = b1[1]; acc[6] = b1[2]; acc[7] = b1[3]; }
#pragma unroll
        for (int k = 0; k < 5; ++k) { const int tt = t + k - 2;
            if (tt >= 0 && tt < SEQ) { const u32x4 w = *(const u32x4*)(U + (size_t)(m + k - 2) * NU + U_XBC + c); float f[8]; unpack8(w, f);
                const f32x4 w0 = *(const f32x4*)(cw + k * 1024 + c), w1 = *(const f32x4*)(cw + k * 1024 + c + 4);
                acc[0] += f[0] * w0[0]; acc[1] += f[1] * w0[1]; acc[2] += f[2] * w0[2]; acc[3] += f[3] * w0[3]; acc[4] += f[4] * w1[0]; acc[5] += f[5] * w1[1]; acc[6] += f[6] * w1[2]; acc[7] += f[7] * w1[3]; } }
        f32x4 o0, o1; o0[0] = siluf_(acc[0]); o0[1] = siluf_(acc[1]); o0[2] = siluf_(acc[2]); o0[3] = siluf_(acc[3]); o1[0] = siluf_(acc[4]); o1[1] = siluf_(acc[5]); o1[2] = siluf_(acc[6]); o1[3] = siluf_(acc[7]);
        *(f32x4*)(XB + (size_t)m * 1024 + c) = o0; *(f32x4*)(XB + (size_t)m * 1024 + c + 4) = o1;
    }
    const float* dtraw = (const float*)(a.ws + WS_DTRAW); float* DT = (float*)(a.ws + WS_DT); const float* dtb = a.in[11] + l * 16;
    for (int it = X.bid * 512 + X.tid; it < T * 16; it += X.G * 512) DT[it] = softplusf_(dtraw[it] + dtb[it & 15]);
}

__device__ __forceinline__ void na_slow_item(const Args& a, int l, int m, int h, LAS float* sc, int lane) {
    const bf16_t* U = (const bf16_t*)(a.ws + WS_U); bf16_t* MIX = (bf16_t*)(a.ws + WS_MIX);
    const int b = m >> 13, t = m & 8191, r = t >> 6, c = t & 63;
    const int r0 = min(max(r - 4, 0), 120), c0 = min(max(c - 8, 0), 48);
    const float* qw = a.in[3] + l * 64; const float* kw = a.in[4] + l * 64; const float* rpb = a.in[5] + (size_t)(l * 8 + h) * 15 * 31;
    const float qv = bf1(U[(size_t)m * NU + U_NAQ + h * 64 + lane]);
    const float qn = qv * rsqrtf(wsum(qv * qv) * (1.f / 64.f) + EPS) * qw[lane] * 0.125f * kw[lane];
    sc[lane] = qn;
    LDS_WAIT();
    float lg[2];
#pragma unroll
    for (int jj = 0; jj < 2; ++jj) { const int j = lane + 64 * jj, kr = r0 + (j >> 4), kc = c0 + (j & 15), kt = b * SEQ + kr * 64 + kc;
        const u32x4* kp = (const u32x4*)(U + (size_t)kt * NU + U_NAK + h * 64); float dot = 0.f, s2 = 0.f;
#pragma unroll
        for (int ch = 0; ch < 8; ++ch) { const u32x4 w = kp[ch]; float f[8]; unpack8(w, f);
#pragma unroll
            for (int e = 0; e < 8; ++e) { dot += sc[ch * 8 + e] * f[e]; s2 += f[e] * f[e]; } }
        lg[jj] = dot * rsqrtf(s2 * (1.f / 64.f) + EPS) + rpb[(kr - r + 7) * 31 + (kc - c + 15)]; }
    const float mx = wmax(fmaxf(lg[0], lg[1]));
    const float p0 = __expf(lg[0] - mx), p1 = __expf(lg[1] - mx); const float inv = 1.0f / wsum(p0 + p1);
    sc[64 + lane] = p0 * inv; sc[128 + lane] = p1 * inv;
    LDS_WAIT();
    float o = 0.f;
#pragma unroll 8
    for (int j = 0; j < 128; ++j) { const int kt = b * SEQ + (r0 + (j >> 4)) * 64 + c0 + (j & 15); o += sc[64 + j] * bf1(U[(size_t)kt * NU + U_NAV + h * 64 + lane]); }
    MIX[(size_t)m * DM + h * 64 + lane] = (bf16_t)(cvtpk(o, 0.f) & 0xffffu);
    LDS_WAIT();
}

__device__ __forceinline__ void swa_slow_item(const Args& a, int l, int m, int hq, LAS float* sc, int lane) {
    const bf16_t* U = (const bf16_t*)(a.ws + WS_U); bf16_t* MIX = (bf16_t*)(a.ws + WS_MIX); const float* rope = (const float*)(a.ws + WS_ROPE);
    const int b = m >> 13, t = m & 8191, kvh = hq >> 2;
    const float* qnw = a.in[6] + l * 64; const float* knw = a.in[7] + l * 64; const float sink = a.in[8][l * 8 + hq];
    const float qv = bf1(U[(size_t)m * NU + U_WAQ + hq * 64 + lane]);
    const float qn = qv * rsqrtf(wsum(qv * qv) * (1.f / 64.f) + EPS) * qnw[lane];
    const float partner = shx(qn, 8);
    const float cs = (lane < 16) ? rope[t * 16 + (lane & 7)] : 1.f, sn = (lane < 16) ? rope[t * 16 + 8 + (lane & 7)] : 0.f;
    const float qr = (lane < 8) ? qn * cs - partner * sn : (lane < 16 ? qn * cs + partner * sn : qn);
    sc[lane] = qr * 0.125f; sc[64 + lane] = knw[lane];
    LDS_WAIT();
    const int lo = max(0, t - 128), hi = min(SEQ - 1, t + 128), n = hi - lo + 1;
    float lg[5]; float mx = sink;
#pragma unroll
    for (int i = 0; i < 5; ++i) { const int kk = lane + 64 * i; lg[i] = -INFINITY;
        if (kk < n) { const int j = lo + kk; const u32x4* kp = (const u32x4*)(U + (size_t)(b * SEQ + j) * NU + U_WAK + kvh * 64);
            float k0[8], k1[8]; unpack8(kp[0], k0); unpack8(kp[1], k1);
            const f32x4 c0 = *(const f32x4*)(rope + j * 16), c1 = *(const f32x4*)(rope + j * 16 + 4), s0 = *(const f32x4*)(rope + j * 16 + 8), s1 = *(const f32x4*)(rope + j * 16 + 12);
            float dot = 0.f, s2 = 0.f;
#pragma unroll
            for (int d = 0; d < 8; ++d) { const float cj = d < 4 ? c0[d & 3] : c1[d & 3], sj = d < 4 ? s0[d & 3] : s1[d & 3];
                const float a0 = k0[d] * sc[64 + d], a1 = k1[d] * sc[64 + 8 + d];
                dot += sc[d] * (a0 * cj - a1 * sj) + sc[8 + d] * (a1 * cj + a0 * sj); s2 += k0[d] * k0[d] + k1[d] * k1[d]; }
#pragma unroll
            for (int ch = 2; ch < 8; ++ch) { float f[8]; unpack8(kp[ch], f);
#pragma unroll
                for (int e = 0; e < 8; ++e) { dot += sc[ch * 8 + e] * sc[64 + ch * 8 + e] * f[e]; s2 += f[e] * f[e]; } }
            lg[i] = dot * rsqrtf(s2 * (1.f / 64.f) + EPS); mx = fmaxf(mx, lg[i]); } }
    mx = wmax(mx);
    float ps = 0.f;
#pragma unroll
    for (int i = 0; i < 5; ++i) { lg[i] = __expf(lg[i] - mx); ps += lg[i]; }
    const float inv = 1.0f / (wsum(ps) + __expf(sink - mx));
#pragma unroll
    for (int i = 0; i < 5; ++i) sc[128 + lane + 64 * i] = lg[i] * inv;
    LDS_WAIT();
    float o = 0.f;
    for (int kk = 0; kk < n; ++kk) o += sc[128 + kk] * bf1(U[(size_t)(b * SEQ + lo + kk) * NU + U_WAV + kvh * 64 + lane]);
    MIX[(size_t)m * DM + 512 + hq * 64 + lane] = (bf16_t)(cvtpk(o, 0.f) & 0xffffu);
    LDS_WAIT();
}

__device__ __forceinline__ void conf_slow_item(const Args& a, int l, int m, int lane) {
    const bf16_t* U = (const bf16_t*)(a.ws + WS_U); bf16_t* MIX = (bf16_t*)(a.ws + WS_MIX);
    const int t = m & 8191, c = 8 * lane;
    const float* dw = a.in[15] + (size_t)l * 31 * 512; const float* db = a.in[16] + l * 512; const float* lw = a.in[17] + l * 512; const float* lb = a.in[18] + l * 512;
    float acc[8]; { const f32x4 b0 = *(const f32x4*)(db + c), b1 = *(const f32x4*)(db + c + 4); acc[0] = b0[0]; acc[1] = b0[1]; acc[2] = b0[2]; acc[3] = b0[3]; acc[4] = b1[0]; acc[5] = b1[1]; acc[6] = b1[2]; acc[7] = b1[3]; }
    for (int k = 0; k < 31; ++k) { const int tt = t + k - 15;
        if (tt >= 0 && tt < SEQ) { const size_t mm = (size_t)(m + k - 15);
            float av[8], gv[8]; unpack8(*(const u32x4*)(U + mm * NU + U_CA + c), av); unpack8(*(const u32x4*)(U + mm * NU + U_CG + c), gv);
            const f32x4 w0 = *(const f32x4*)(dw + k * 512 + c), w1 = *(const f32x4*)(dw + k * 512 + c + 4);
#pragma unroll
            for (int e = 0; e < 8; ++e) acc[e] += (e < 4 ? w0[e & 3] : w1[e & 3]) * av[e] * sigmoidf_(gv[e]); } }
    float s = 0.f;
#pragma unroll
    for (int e = 0; e < 8; ++e) s += acc[e];
    const float mu = wsum(s) * (1.f / 512.f); float q = 0.f;
#pragma unroll
    for (int e = 0; e < 8; ++e) { acc[e] -= mu; q += acc[e] * acc[e]; }
    const float rstd = rsqrtf(wsum(q) * (1.f / 512.f) + EPS);
    const f32x4 lw0 = *(const f32x4*)(lw + c), lw1 = *(const f32x4*)(lw + c + 4), lb0 = *(const f32x4*)(lb + c), lb1 = *(const f32x4*)(lb + c + 4);
    float y[8];
#pragma unroll
    for (int e = 0; e < 8; ++e) y[e] = siluf_(acc[e] * rstd * (e < 4 ? lw0[e & 3] : lw1[e & 3]) + (e < 4 ? lb0[e & 3] : lb1[e & 3]));
    u32x4 o; o.x = cvtpk(y[0], y[1]); o.y = cvtpk(y[2], y[3]); o.z = cvtpk(y[4], y[5]); o.w = cvtpk(y[6], y[7]);
    *(u32x4*)(MIX + (size_t)m * DM + 1536 + c) = o;
}

__device__ __forceinline__ void ssd_slow_unit(const Args& a, int l, int unit, int tid) {
    const int b = unit >> 4, dir = (unit >> 3) & 1, h = unit & 7, g = h >> 2;
    const float A = -__expf(a.in[12][l * 16 + dir * 8 + h]);
    const float* XB = (const float*)(a.ws + WS_XBC); const float* DT = (const float*)(a.ws + WS_DT);
    float* YS = (float*)(a.ws + WS_YSSD) + (size_t)dir * T * 512;
    const int p = tid >> 3, q = tid & 7;
    float st[16];
#pragma unroll
    for (int i = 0; i < 16; ++i) st[i] = 0.f;
#pragma unroll 2
    for (int s = 0; s < SEQ; ++s) {
        const int t = dir ? SEQ - 1 - s : s; const size_t m = (size_t)b * SEQ + t;
        const float dtv = DT[m * 16 + dir * 8 + h];
        const float dA = __expf(dtv * A);
        const float xv = XB[m * 1024 + h * 64 + p] * dtv;
        const f32x4* bp = (const f32x4*)(XB + m * 1024 + 512 + g * 128 + 16 * q); const f32x4* cp = (const f32x4*)(XB + m * 1024 + 768 + g * 128 + 16 * q);
        float part = 0.f;
#pragma unroll
        for (int i = 0; i < 4; ++i) { const f32x4 bv = bp[i], cv = cp[i];
#pragma unroll
            for (int e = 0; e < 4; ++e) { st[4 * i + e] = dA * st[4 * i + e] + xv * bv[e]; part += st[4 * i + e] * cv[e]; } }
        part += shx(part, 1); part += shx(part, 2); part += shx(part, 4);
        if (q == 0) YS[m * 512 + h * 64 + p] = part;
    }
}

__device__ __forceinline__ void phase_mix1_slow(const Args& a, const Ctx& X, int l) {
    if (X.bid < 32) { ssd_slow_unit(a, l, X.bid, X.tid); return; }
    LAS float* sc = (LAS float*)(X.lds + X.wave * 2048);
    const int gw = (X.bid - 32) * 8 + X.wave, NGW = (X.G - 32) * 8;
    for (int it = gw; it < T * 8; it += NGW) na_slow_item(a, l, it >> 3, it & 7, sc, X.lane);
    for (int it = gw; it < T * 8; it += NGW) swa_slow_item(a, l, it >> 3, it & 7, sc, X.lane);
    for (int it = gw; it < T; it += NGW) conf_slow_item(a, l, it, X.lane);
}

__device__ __forceinline__ void phase_ssd_fin_slow(const Args& a, const Ctx& X, int l) {
    const bf16_t* U = (const bf16_t*)(a.ws + WS_U); bf16_t* MIX = (bf16_t*)(a.ws + WS_MIX); const float* XB = (const float*)(a.ws + WS_XBC);
    const float* YF = (const float*)(a.ws + WS_YSSD); const float* YB = YF + (size_t)T * 512;
    const float* nw = a.in[14] + l * 512; const float dd = a.in[13][l * 8 + (X.lane >> 3)];
    const int c = 8 * X.lane;
    for (int m = X.gw; m < T; m += X.NGW) {
        float v[8];
        { const f32x4 f0 = *(const f32x4*)(YF + (size_t)m * 512 + c), f1 = *(const f32x4*)(YF + (size_t)m * 512 + c + 4), b0 = *(const f32x4*)(YB + (size_t)m * 512 + c), b1 = *(const f32x4*)(YB + (size_t)m * 512 + c + 4);
          const f32x4 x0 = *(const f32x4*)(XB + (size_t)m * 1024 + c), x1 = *(const f32x4*)(XB + (size_t)m * 1024 + c + 4);
          float z[8]; unpack8(*(const u32x4*)(U + (size_t)m * NU + U_Z + c), z);
#pragma unroll
          for (int e = 0; e < 8; ++e) { const float y = (e < 4 ? f0[e & 3] + b0[e & 3] + x0[e & 3] * dd : f1[e & 3] + b1[e & 3] + x1[e & 3] * dd); v[e] = y * siluf_(z[e]); } }
        float ss = 0.f;
#pragma unroll
        for (int e = 0; e < 8; ++e) ss += v[e] * v[e];
        const float rstd = rsqrtf(wsum(ss) * (1.f / 512.f) + EPS);
        const f32x4 w0 = *(const f32x4*)(nw + c), w1 = *(const f32x4*)(nw + c + 4);
        u32x4 o; o.x = cvtpk(v[0] * rstd * w0[0], v[1] * rstd * w0[1]); o.y = cvtpk(v[2] * rstd * w0[2], v[3] * rstd * w0[3]); o.z = cvtpk(v[4] * rstd * w1[0], v[5] * rstd * w1[1]); o.w = cvtpk(v[6] * rstd * w1[2], v[7] * rstd * w1[3]);
        *(u32x4*)(MIX + (size_t)m * DM + 1024 + c) = o;
    }
}
typedef short v4i16_t __attribute__((ext_vector_type(4)));
__device__ __forceinline__ v4i16_t trr(const LAS unsigned char* p) { return __builtin_amdgcn_ds_read_tr16_b64_v4i16((LAS v4i16_t*)p); }
__device__ __forceinline__ bf16x8 cat8(v4i16_t lo, v4i16_t hi) { return (bf16x8){lo[0], lo[1], lo[2], lo[3], hi[0], hi[1], hi[2], hi[3]}; }
#define MFMA16(a, b, c) __builtin_amdgcn_mfma_f32_16x16x32_bf16((a), (b), (c), 0, 0, 0)

constexpr int S1_XT = 0, S1_XS = 544, S1_BT = 69632, S1_BS = 272, S1_CT = 104448, S1_CS = 272, S1_VEC = 139264;
static_assert(S1_VEC + 4 * 6 * 128 * 4 <= RMAPL_OFF, "S1 LDS map");

__device__ __forceinline__ void ssd_s1_unit(const Args& a, const Ctx& X, int l, int unit) {
    const int b = unit >> 7, c = (unit >> 1) & 63, g = unit & 1;
    const int m0 = b * SEQ + c * 128, bc = b * 64 + c;
    const bf16_t* U = (const bf16_t*)(a.ws + WS_U);
    bf16_t* XBCp = (bf16_t*)(a.ws + WS_XBC);
    float* EF = (float*)(a.ws + WS_DT);
    float* CDEC = (float*)(a.ws + WS_CDEC);
    LAS unsigned char* L = X.lds;
    LAS float* VEC = (LAS float*)(L + S1_VEC);
    {
        const int dir = X.wave >> 2, hh = X.wave & 3, h = g * 4 + hh;
        const float A = -__expf(a.in[12][l * 16 + dir * 8 + h]); const float bias = a.in[11][l * 16 + dir * 8 + h];
        const float* dtraw = (const float*)(a.ws + WS_DTRAW);
        const float d0 = softplusf_(dtraw[(size_t)(m0 + X.lane) * 16 + dir * 8 + h] + bias), d1 = softplusf_(dtraw[(size_t)(m0 + 64 + X.lane) * 16 + dir * 8 + h] + bias);
        float c0 = d0 * A, c1 = d1 * A; const float v0 = c0, v1 = c1;
#pragma unroll
        for (int o = 1; o < 64; o <<= 1) { const float t0 = shup_f(c0, o), t1 = shup_f(c1, o); if (X.lane >= o) { c0 += t0; c1 += t1; } }
        const float tot0 = shl_f(c0, 63); c1 += tot0; const float total = shl_f(c1, 63);
        LAS float* V = VEC + hh * 768;
        if (dir == 0) { V[0 * 128 + X.lane] = c0; V[0 * 128 + 64 + X.lane] = c1; V[1 * 128 + X.lane] = d0; V[1 * 128 + 64 + X.lane] = d1;
            V[4 * 128 + X.lane] = d0 * __expf(total - c0); V[4 * 128 + 64 + X.lane] = d1 * __expf(total - c1);
            EF[(size_t)(m0 + X.lane) * 16 + h] = __expf(c0); EF[(size_t)(m0 + 64 + X.lane) * 16 + h] = __expf(c1); }
        else { const float x0 = c0 - v0, x1 = c1 - v1;
            V[2 * 128 + X.lane] = x0; V[2 * 128 + 64 + X.lane] = x1; V[3 * 128 + X.lane] = d0; V[3 * 128 + 64 + X.lane] = d1;
            V[5 * 128 + X.lane] = d0 * __expf(x0); V[5 * 128 + 64 + X.lane] = d1 * __expf(x1);
            EF[(size_t)(m0 + X.lane) * 16 + 8 + h] = __expf(total - x0); EF[(size_t)(m0 + 64 + X.lane) * 16 + 8 + h] = __expf(total - x1); }
        if (X.lane == 0) CDEC[(dir * 128 + bc) * 8 + h] = __expf(total);
    }
    {
        const int cg = X.tid & 63, rb = X.tid >> 6;
        const int sc = cg < 32 ? g * 256 + 8 * cg : (cg < 48 ? 512 + g * 128 + 8 * (cg - 32) : 768 + g * 128 + 8 * (cg - 48));
        const float* cw = a.in[9] + (size_t)l * 5 * 1024 + sc; const float* cb = a.in[10] + (size_t)l * 1024 + sc;
        float w[5][8], bs[8];
#pragma unroll
        for (int k = 0; k < 5; ++k) { const f32x4 w0 = *(const f32x4*)(cw + k * 1024), w1 = *(const f32x4*)(cw + k * 1024 + 4); w[k][0] = w0[0]; w[k][1] = w0[1]; w[k][2] = w0[2]; w[k][3] = w0[3]; w[k][4] = w1[0]; w[k][5] = w1[1]; w[k][6] = w1[2]; w[k][7] = w1[3]; }
        { const f32x4 b0 = *(const f32x4*)cb, b1 = *(const f32x4*)(cb + 4); bs[0] = b0[0]; bs[1] = b0[1]; bs[2] = b0[2]; bs[3] = b0[3]; bs[4] = b1[0]; bs[5] = b1[1]; bs[6] = b1[2]; bs[7] = b1[3]; }
        LAS unsigned char* dstl = cg < 32 ? L + S1_XT + cg * 16 : (cg < 48 ? L + S1_BT + (cg - 32) * 16 : L + S1_CT + (cg - 48) * 16);
        const int dstride = cg < 32 ? S1_XS : S1_BS;
        const int t0 = c * 128 + rb * 16;
        u32x4 raw[20];
#pragma unroll
        for (int i = 0; i < 20; ++i) { const int tt = t0 + i - 2; raw[i] = (u32x4){0u, 0u, 0u, 0u}; if (tt >= 0 && tt < SEQ) raw[i] = *(const u32x4*)(U + (size_t)(b * SEQ + tt) * NU + U_XBC + sc); }
#pragma unroll
        for (int i = 0; i < 16; ++i) {
            float acc[8];
#pragma unroll
            for (int e = 0; e < 8; ++e) acc[e] = bs[e];
#pragma unroll
            for (int k = 0; k < 5; ++k) { float f[8]; unpack8(raw[i + k], f);
#pragma unroll
                for (int e = 0; e < 8; ++e) acc[e] += w[k][e] * f[e]; }
            u32x4 o; o.x = cvtpk(siluf_(acc[0]), siluf_(acc[1])); o.y = cvtpk(siluf_(acc[2]), siluf_(acc[3])); o.z = cvtpk(siluf_(acc[4]), siluf_(acc[5])); o.w = cvtpk(siluf_(acc[6]), siluf_(acc[7]));
            *(LAS u32x4*)(dstl + (rb * 16 + i) * dstride) = o;
            if (cg < 32 || cg >= 48) *(u32x4*)(XBCp + (size_t)(m0 + rb * 16 + i) * 1024 + sc) = o;
        }
    }
    LBAR();
    const int fr = X.lane & 15, gq = X.lane >> 4;
    {
        const int w = X.wave, lrow = 16 * w + fr;
        bf16x8 cfr[4];
#pragma unroll
        for (int ks = 0; ks < 4; ++ks) cfr[ks] = *(const LAS bf16x8*)(L + S1_CT + lrow * S1_CS + (32 * ks + 8 * gq) * 2);
        f32x4 d[8];
#pragma unroll
        for (int st = 0; st < 8; ++st) { d[st] = (f32x4){0.f, 0.f, 0.f, 0.f};
#pragma unroll
            for (int ks = 0; ks < 4; ++ks) { const bf16x8 bfr = *(const LAS bf16x8*)(L + S1_BT + (16 * st + fr) * S1_BS + (32 * ks + 8 * gq) * 2); d[st] = MFMA16(bfr, cfr[ks], d[st]); } }
        bf16_t* YD = (bf16_t*)(a.ws + WS_YSSD);
#pragma unroll 1
        for (int hh = 0; hh < 4; ++hh) {
            const LAS float* V = VEC + hh * 768;
            const float cfl = V[lrow], cbxl = V[2 * 128 + lrow];
            f32x4 yacc[4];
#pragma unroll
            for (int pt = 0; pt < 4; ++pt) yacc[pt] = (f32x4){0.f, 0.f, 0.f, 0.f};
#pragma unroll
            for (int kk = 0; kk < 4; ++kk) {
                float wv[8];
#pragma unroll
                for (int hf = 0; hf < 2; ++hf) { const int st = 2 * kk + hf, s0 = 16 * st + 4 * gq;
                    const f32x4 cfs = *(const LAS f32x4*)(V + s0), dt0s = *(const LAS f32x4*)(V + 128 + s0), cbxs = *(const LAS f32x4*)(V + 256 + s0), dt1s = *(const LAS f32x4*)(V + 384 + s0);
#pragma unroll
                    for (int r = 0; r < 4; ++r) { const int s = s0 + r; float ww = 0.f;
                        if (st < w) ww = __expf(cfl - cfs[r]) * dt0s[r];
                        else if (st > w) ww = __expf(cbxs[r] - cbxl) * dt1s[r];
                        else { if (s <= lrow) ww = __expf(cfl - cfs[r]) * dt0s[r]; if (s >= lrow) ww += __expf(cbxs[r] - cbxl) * dt1s[r]; }
                        wv[hf * 4 + r] = d[st][r] * ww; } }
                u32x4 wp; wp.x = cvtpk(wv[0], wv[1]); wp.y = cvtpk(wv[2], wv[3]); wp.z = cvtpk(wv[4], wv[5]); wp.w = cvtpk(wv[6], wv[7]);
                const bf16x8 wfr = __builtin_bit_cast(bf16x8, wp);
#pragma unroll
                for (int pt = 0; pt < 4; ++pt) { const LAS unsigned char* xp = L + S1_XT + (32 * kk + 4 * gq + (fr >> 2)) * S1_XS + (hh * 64 + 16 * pt + 4 * (fr & 3)) * 2;
                    const bf16x8 xfr = cat8(trr(xp), trr(xp + 16 * S1_XS)); yacc[pt] = MFMA16(xfr, wfr, yacc[pt]); }
            }
#pragma unroll
            for (int pt = 0; pt < 4; ++pt) { u32x2 o; o.x = cvtpk(yacc[pt][0], yacc[pt][1]); o.y = cvtpk(yacc[pt][2], yacc[pt][3]); *(u32x2*)(YD + (size_t)(m0 + lrow) * 512 + (g * 4 + hh) * 64 + 16 * pt + 4 * gq) = o; }
        }
    }
    {
        const int dir = X.wave >> 2, hh = X.wave & 3, h = g * 4 + hh;
        const LAS float* WV = VEC + hh * 768 + (dir ? 5 : 4) * 128;
        bf16x8 xs[4][4];
#pragma unroll
        for (int ks = 0; ks < 4; ++ks) { const f32x4 w0 = *(const LAS f32x4*)(WV + 32 * ks + 8 * gq), w1 = *(const LAS f32x4*)(WV + 32 * ks + 8 * gq + 4);
#pragma unroll
            for (int pt = 0; pt < 4; ++pt) { const LAS unsigned char* xp = L + S1_XT + (32 * ks + 8 * gq + (fr >> 2)) * S1_XS + (hh * 64 + 16 * pt + 4 * (fr & 3)) * 2;
                const v4i16_t lo = trr(xp), hi = trr(xp + 4 * S1_XS);
                const u32x2 lw = __builtin_bit_cast(u32x2, lo), hw = __builtin_bit_cast(u32x2, hi);
                u32x4 o; o.x = cvtpk(bflo(lw.x) * w0[0], bfhi(lw.x) * w0[1]); o.y = cvtpk(bflo(lw.y) * w0[2], bfhi(lw.y) * w0[3]); o.z = cvtpk(bflo(hw.x) * w1[0], bfhi(hw.x) * w1[1]); o.w = cvtpk(bflo(hw.y) * w1[2], bfhi(hw.y) * w1[3]);
                xs[ks][pt] = __builtin_bit_cast(bf16x8, o); } }
        bf16_t* ST = (bf16_t*)(a.ws + WS_STATE) + ((size_t)((dir * 128 + bc) * 8 + h)) * 64 * 128;
#pragma unroll 1
        for (int half = 0; half < 2; ++half) {
            f32x4 acc[4][4];
#pragma unroll
            for (int nt = 0; nt < 4; ++nt)
#pragma unroll
                for (int pt = 0; pt < 4; ++pt) acc[nt][pt] = (f32x4){0.f, 0.f, 0.f, 0.f};
#pragma unroll
            for (int ks = 0; ks < 4; ++ks) {
                bf16x8 af[4];
#pragma unroll
                for (int nt = 0; nt < 4; ++nt) { const LAS unsigned char* bp = L + S1_BT + (32 * ks + 8 * gq + (fr >> 2)) * S1_BS + (16 * (4 * half + nt) + 4 * (fr & 3)) * 2; af[nt] = cat8(trr(bp), trr(bp + 4 * S1_BS)); }
#pragma unroll
                for (int nt = 0; nt < 4; ++nt)
#pragma unroll
                    for (int pt = 0; pt < 4; ++pt) acc[nt][pt] = MFMA16(af[nt], xs[ks][pt], acc[nt][pt]);
            }
#pragma unroll
            for (int nt = 0; nt < 4; ++nt)
#pragma unroll
                for (int pt = 0; pt < 4; ++pt) { u32x2 o; o.x = cvtpk(acc[nt][pt][0], acc[nt][pt][1]); o.y = cvtpk(acc[nt][pt][2], acc[nt][pt][3]); *(u32x2*)(ST + (size_t)(16 * pt + fr) * 128 + 16 * (4 * half + nt) + 4 * gq) = o; }
        }
    }
    LBAR();
}

__device__ __forceinline__ void phase_ssd_scan(const Args& a, const Ctx& X) {
    const bf16_t* ST = (const bf16_t*)(a.ws + WS_STATE); const float* CDEC = (const float*)(a.ws + WS_CDEC); bf16_t* PREV = (bf16_t*)(a.ws + WS_PREV);
#pragma unroll 1
    for (int w = X.gw; w < 2 * 2 * 8 * 64; w += X.NGW) {
        const int p = w & 63, h = (w >> 6) & 7, b = (w >> 9) & 1, dir = w >> 10;
        const int c0 = dir ? 63 : 0, cs = dir ? -1 : 1;
        const size_t cstr = (size_t)8 * 64 * 128;
        const size_t base = ((size_t)((dir * 128 + b * 64) * 8 + h) * 64 + p) * 128 + 2 * X.lane;
        const int dbase = (dir * 128 + b * 64) * 8 + h;
        unsigned swA[16], swB[16]; float dcA[16], dcB[16];
        float r0 = 0.f, r1 = 0.f;
#define SCAN_LOAD(sw, dc, k) _Pragma("unroll") for (int j = 0; j < 16; ++j) { const int c = c0 + cs * (16 * (k) + j); sw[j] = *(const unsigned*)(ST + base + (size_t)c * cstr); dc[j] = CDEC[dbase + c * 8]; }
#define SCAN_RUN(sw, dc, k) _Pragma("unroll") for (int j = 0; j < 16; ++j) { const int c = c0 + cs * (16 * (k) + j); *(unsigned*)(PREV + base + (size_t)c * cstr) = cvtpk(r0, r1); r0 = r0 * dc[j] + bflo(sw[j]); r1 = r1 * dc[j] + bfhi(sw[j]); }
        SCAN_LOAD(swA, dcA, 0);
        SCAN_LOAD(swB, dcB, 1);
        SCAN_RUN(swA, dcA, 0);
        SCAN_LOAD(swA, dcA, 2);
        SCAN_RUN(swB, dcB, 1);
        SCAN_LOAD(swB, dcB, 3);
        SCAN_RUN(swA, dcA, 2);
        SCAN_RUN(swB, dcB, 3);
#undef SCAN_LOAD
#undef SCAN_RUN
    }
}

__device__ __forceinline__ void ssd_s3_unit(const Args& a, const Ctx& X, int l, int unit) {
    const int b = unit >> 7, c = (unit >> 1) & 63, lh = unit & 1, h = X.wave, g = h >> 2;
    const int m0 = b * SEQ + c * 128 + 64 * lh, bc = b * 64 + c;
    const int fr = X.lane & 15, gq = X.lane >> 4;
    const bf16_t* XBCp = (const bf16_t*)(a.ws + WS_XBC); const bf16_t* PREV = (const bf16_t*)(a.ws + WS_PREV); const bf16_t* U = (const bf16_t*)(a.ws + WS_U);
    const float* EF = (const float*)(a.ws + WS_DT); const bf16_t* YD = (const bf16_t*)(a.ws + WS_YSSD); bf16_t* MIX = (bf16_t*)(a.ws + WS_MIX);
    f32x4 accf[4][4];
#pragma unroll
    for (int lt = 0; lt < 4; ++lt)
#pragma unroll
        for (int pt = 0; pt < 4; ++pt) accf[lt][pt] = (f32x4){0.f, 0.f, 0.f, 0.f};
    float esc[2][4];
#pragma unroll
    for (int lt = 0; lt < 4; ++lt) { const size_t m = (size_t)(m0 + 16 * lt + fr); esc[0][lt] = EF[m * 16 + h]; esc[1][lt] = EF[m * 16 + 8 + h]; }
    u32x4 cw[2][4]; bf16x8 pf[2][4];
#define S3_LOADC(buf, ks) do { _Pragma("unroll") for (int lt = 0; lt < 4; ++lt) cw[buf][lt] = *(const u32x4*)(XBCp + (size_t)(m0 + 16 * lt + fr) * 1024 + 768 + g * 128 + 32 * (ks) + 8 * gq); } while (0)
#define S3_LOADP(buf, ks, dir) do { const bf16_t* pp = PREV + ((size_t)(((dir) * 128 + bc) * 8 + h) * 64 + fr) * 128 + 8 * gq + 32 * (ks); \
        _Pragma("unroll") for (int pt = 0; pt < 4; ++pt) pf[buf][pt] = *(const bf16x8*)(pp + (size_t)(16 * pt) * 128); } while (0)
    S3_LOADC(0, 0); S3_LOADP(0, 0, 0); __builtin_amdgcn_sched_barrier(0);
#pragma unroll
    for (int s = 0; s < 8; ++s) { const int ks = s >> 1, dir = s & 1;
        if (s < 7) { if ((s & 1) == 0) S3_LOADP(1, ks, 1); else { S3_LOADP(0, ks + 1, 0); if ((ks & 1) == 0) S3_LOADC(1, ks + 1); else S3_LOADC(0, ks + 1); } }
        __builtin_amdgcn_sched_barrier(0);
        bf16x8 cs[4];
#pragma unroll
        for (int lt = 0; lt < 4; ++lt) { float f[8]; unpack8(cw[ks & 1][lt], f); const float e = esc[dir][lt];
            u32x4 o; o.x = cvtpk(f[0] * e, f[1] * e); o.y = cvtpk(f[2] * e, f[3] * e); o.z = cvtpk(f[4] * e, f[5] * e); o.w = cvtpk(f[6] * e, f[7] * e); cs[lt] = __builtin_bit_cast(bf16x8, o); }
#pragma unroll
        for (int pt = 0; pt < 4; ++pt)
#pragma unroll
            for (int lt = 0; lt < 4; ++lt) accf[lt][pt] = MFMA16(pf[s & 1][pt], cs[lt], accf[lt][pt]);
    }
#undef S3_LOADC
#undef S3_LOADP
    const float dd = a.in[13][l * 8 + h];
    const float* nw = a.in[14] + l * 512;
    f32x4 nwv[4];
#pragma unroll
    for (int pt = 0; pt < 4; ++pt) nwv[pt] = *(const f32x4*)(nw + h * 64 + 16 * pt + 4 * gq);
    LAS float* red = (LAS float*)X.lds;
    u32x2 ep[2][4][3];
#define S3_EPLOAD(buf, lt) do { const size_t m_ = (size_t)(m0 + 16 * (lt) + fr); _Pragma("unroll") for (int pt = 0; pt < 4; ++pt) { const int ch = h * 64 + 16 * pt + 4 * gq; \
        ep[buf][pt][0] = *(const u32x2*)(YD + m_ * 512 + ch); ep[buf][pt][1] = *(const u32x2*)(XBCp + m_ * 1024 + ch); ep[buf][pt][2] = *(const u32x2*)(U + m_ * NU + U_Z + ch); } } while (0)
    S3_EPLOAD(0, 0); __builtin_amdgcn_sched_barrier(0);
#pragma unroll
    for (int lt = 0; lt < 4; ++lt) { float ss = 0.f;
        if (lt < 3) { if ((lt & 1) == 0) S3_EPLOAD(1, lt + 1); else S3_EPLOAD(0, lt + 1); }
        __builtin_amdgcn_sched_barrier(0);
#pragma unroll
        for (int pt = 0; pt < 4; ++pt) {
            const u32x2 yw = ep[lt & 1][pt][0], xw = ep[lt & 1][pt][1], zw = ep[lt & 1][pt][2]; const f32x4 yd = (f32x4){bflo(yw.x), bfhi(yw.x), bflo(yw.y), bfhi(yw.y)};
            const float xv[4] = {bflo(xw.x), bfhi(xw.x), bflo(xw.y), bfhi(xw.y)}, zv[4] = {bflo(zw.x), bfhi(zw.x), bflo(zw.y), bfhi(zw.y)};
            f32x4 v;
#pragma unroll
            for (int r = 0; r < 4; ++r) { const float val = accf[lt][pt][r] + yd[r] + xv[r] * dd; v[r] = val * siluf_(zv[r]); ss += v[r] * v[r]; }
            accf[lt][pt] = v; }
        ss += shx(ss, 16); ss += shx(ss, 32);
        if (gq == 0) red[(16 * lt + fr) * 8 + h] = ss;
        asm volatile("" ::: "memory"); }
#undef S3_EPLOAD
    LBAR();
#pragma unroll
    for (int lt = 0; lt < 4; ++lt) { const size_t m = (size_t)(m0 + 16 * lt + fr);
        const f32x4 r0 = *(const LAS f32x4*)(red + (16 * lt + fr) * 8), r1 = *(const LAS f32x4*)(red + (16 * lt + fr) * 8 + 4);
        const float rstd = rsqrtf(((r0[0] + r0[1]) + (r0[2] + r0[3]) + (r1[0] + r1[1]) + (r1[2] + r1[3])) * (1.f / 512.f) + EPS);
#pragma unroll
        for (int pt = 0; pt < 4; ++pt) { const int ch = h * 64 + 16 * pt + 4 * gq; const f32x4 w = nwv[pt]; const f32x4 v = accf[lt][pt];
            u32x2 o; o.x = cvtpk(v[0] * rstd * w[0], v[1] * rstd * w[1]); o.y = cvtpk(v[2] * rstd * w[2], v[3] * rstd * w[3]);
            *(u32x2*)(MIX + m * DM + 1024 + ch) = o; } }
    LBAR();
}

constexpr int AT_RS = 144;

__device__ __forceinline__ float rope_frev(int e) { return e == 0 ? 0.15915494309189535f : e == 1 ? 0.03086376340470123f : e == 2 ? 0.0059851857127137054f : e == 3 ? 0.001160663641240061f : e == 4 ? 0.00022507907903927653f : e == 5 ? 4.3647952792802891e-05f : e == 6 ? 8.4643308082414014e-06f : 1.6414262627950345e-06f; }
__device__ __forceinline__ void rope_cs(int pos, float frev, float& c, float& s) { const float r = (float)pos * frev, fr = r - __builtin_floorf(r); c = __builtin_amdgcn_cosf(fr); s = __builtin_amdgcn_sinf(fr); }

constexpr int SW_ROWS = 304, SW_KT = 0, SW_VT = SW_ROWS * AT_RS;
struct SwaPre { u32x4 kw[5], vw[5], q0, q1; };
__device__ __forceinline__ void swa_issue(const Args& a, const Ctx& X, int unit, SwaPre& P) {
    const int b = unit >> 9, kvh = (unit >> 8) & 1, qb = unit & 255, q0 = 32 * qb, kbase = q0 - 128, sub = X.tid & 7;
    const bf16_t* U = (const bf16_t*)(a.ws + WS_U);
#pragma unroll
    for (int i = 0; i < 5; ++i) { const int it = X.tid + 512 * i, row = it >> 3, pos = kbase + row; const bool ok = it < SW_ROWS * 8 && pos >= 0 && pos < SEQ;
        P.kw[i] = (u32x4){0u, 0u, 0u, 0u}; P.vw[i] = (u32x4){0u, 0u, 0u, 0u};
        if (ok) { const bf16_t* p = U + (size_t)(b * SEQ + pos) * NU + kvh * 64 + 8 * sub; P.kw[i] = *(const u32x4*)(p + U_WAK); P.vw[i] = *(const u32x4*)(p + U_WAV); } }
    const int hq = kvh * 4 + (X.wave >> 1), qt = X.wave & 1, posq = q0 + 16 * qt + (X.lane & 15), gq = X.lane >> 4;
    const bf16_t* qp = U + (size_t)(b * SEQ + posq) * NU + U_WAQ + hq * 64 + 8 * gq;
    P.q0 = *(const u32x4*)qp; P.q1 = *(const u32x4*)(qp + 32);
}
__device__ __forceinline__ void swa_fast_unit(const Args& a, const Ctx& X, int l, int unit, SwaPre& P, int next_unit) {
    const int b = unit >> 9, kvh = (unit >> 8) & 1, qb = unit & 255, q0 = 32 * qb, kbase = q0 - 128;
    bf16_t* MIX = (bf16_t*)(a.ws + WS_MIX);
    LAS unsigned char* L = X.lds;
    {
        const float* knw = a.in[7] + l * 64; const int sub = X.tid & 7;
        const f32x4 w0 = *(const f32x4*)(knw + 8 * sub), w1 = *(const f32x4*)(knw + 8 * sub + 4);
#pragma unroll
        for (int i = 0; i < 5; ++i) { const int it = X.tid + 512 * i, row = it >> 3;
            float f[8]; unpack8(P.kw[i], f); float ss = 0.f;
#pragma unroll
            for (int e = 0; e < 8; ++e) ss += f[e] * f[e];
            ss += shx(ss, 1); ss += shx(ss, 2); ss += shx(ss, 4);
            const float rstd = rsqrtf(ss * (1.f / 64.f) + EPS);
#pragma unroll
            for (int e = 0; e < 8; ++e) f[e] *= rstd * (e < 4 ? w0[e & 3] : w1[e & 3]);
            u32x4 o; o.x = cvtpk(f[0], f[1]); o.y = cvtpk(f[2], f[3]); o.z = cvtpk(f[4], f[5]); o.w = cvtpk(f[6], f[7]);
            if (it < SW_ROWS * 8) { *(LAS u32x4*)(L + SW_KT + row * AT_RS + sub * 16) = o; *(LAS u32x4*)(L + SW_VT + row * AT_RS + sub * 16) = P.vw[i]; } }
    }
    const u32x4 qr0 = P.q0, qr1 = P.q1;
    LBAR();
    {
        const int e = X.tid & 7; const float frev = rope_frev(e);
#pragma unroll
        for (int i = 0; i < 5; ++i) { const int it = X.tid + 512 * i, row = it >> 3;
            if (it < SW_ROWS * 8) { LAS bf16_t* kp = (LAS bf16_t*)(L + SW_KT + row * AT_RS) + e; const float x1 = bf1(kp[0]), x2 = bf1(kp[8]); float cs, sn; rope_cs(kbase + row, frev, cs, sn);
                const unsigned o = cvtpk(x1 * cs - x2 * sn, x2 * cs + x1 * sn); kp[0] = (bf16_t)(o & 0xffffu); kp[8] = (bf16_t)(o >> 16); } }
    }
    LBAR();
    const int fr = X.lane & 15, gq = X.lane >> 4;
    const int hq = kvh * 4 + (X.wave >> 1), qt = X.wave & 1, q1 = q0 + 16 * qt, posq = q1 + fr;
    const size_t m = (size_t)(b * SEQ + posq);
    bf16x8 qf[2];
    {
        const float* qnw = a.in[6] + l * 64;
        float q[2][8]; unpack8(qr0, q[0]); unpack8(qr1, q[1]);
        float ss = 0.f;
#pragma unroll
        for (int e = 0; e < 8; ++e) ss += q[0][e] * q[0][e] + q[1][e] * q[1][e];
        ss += shx(ss, 16); ss += shx(ss, 32);
        const float rstd = rsqrtf(ss * (1.f / 64.f) + EPS);
#pragma unroll
        for (int ks = 0; ks < 2; ++ks) { const f32x4 w0 = *(const f32x4*)(qnw + 32 * ks + 8 * gq), w1 = *(const f32x4*)(qnw + 32 * ks + 8 * gq + 4);
#pragma unroll
            for (int e = 0; e < 8; ++e) q[ks][e] *= rstd * (e < 4 ? w0[e & 3] : w1[e & 3]); }
#pragma unroll
        for (int e = 0; e < 8; ++e) { const float pr = shx(q[0][e], 16); float cj, sj; rope_cs(posq, rope_frev(e), cj, sj);
            q[0][e] = gq == 0 ? q[0][e] * cj - pr * sj : (gq == 1 ? q[0][e] * cj + pr * sj : q[0][e]); }
#pragma unroll
        for (int ks = 0; ks < 2; ++ks) { u32x4 o; o.x = cvtpk(q[ks][0] * 0.125f, q[ks][1] * 0.125f); o.y = cvtpk(q[ks][2] * 0.125f, q[ks][3] * 0.125f); o.z = cvtpk(q[ks][4] * 0.125f, q[ks][5] * 0.125f); o.w = cvtpk(q[ks][6] * 0.125f, q[ks][7] * 0.125f);
            qf[ks] = __builtin_bit_cast(bf16x8, o); }
    }
    const float sink = a.in[8][l * 8 + hq];
    if (next_unit >= 0) swa_issue(a, X, next_unit, P);
    f32x4 st[18];
#pragma unroll
    for (int t = 0; t < 18; ++t) { st[t] = (f32x4){0.f, 0.f, 0.f, 0.f};
#pragma unroll
        for (int ks = 0; ks < 2; ++ks) { const bf16x8 kf = *(const LAS bf16x8*)(L + SW_KT + (16 * (qt + t) + fr) * AT_RS + (32 * ks + 8 * gq) * 2); st[t] = MFMA16(kf, qf[ks], st[t]); } }
    float mx = sink;
#pragma unroll
    for (int t = 0; t < 18; ++t)
#pragma unroll
        for (int r = 0; r < 4; ++r) { const int rel = 16 * t + 4 * gq + r, posk = kbase + 16 * qt + rel; const bool ok = rel >= fr && rel <= 256 + fr && posk >= 0 && posk < SEQ;
            st[t][r] = ok ? st[t][r] : -INFINITY; mx = fmaxf(mx, st[t][r]); }
    mx = fmaxf(mx, shx(mx, 16)); mx = fmaxf(mx, shx(mx, 32));
    float sum = 0.f;
#pragma unroll
    for (int t = 0; t < 18; ++t)
#pragma unroll
        for (int r = 0; r < 4; ++r) { st[t][r] = __expf(st[t][r] - mx); sum += st[t][r]; }
    sum += shx(sum, 16); sum += shx(sum, 32);
    const float inv = 1.0f / (sum + __expf(sink - mx));
    f32x4 o[4];
#pragma unroll
    for (int dt = 0; dt < 4; ++dt) o[dt] = (f32x4){0.f, 0.f, 0.f, 0.f};
#pragma unroll
    for (int kk = 0; kk < 9; ++kk) {
        u32x4 pw; pw.x = cvtpk(st[2 * kk][0], st[2 * kk][1]); pw.y = cvtpk(st[2 * kk][2], st[2 * kk][3]); pw.z = cvtpk(st[2 * kk + 1][0], st[2 * kk + 1][1]); pw.w = cvtpk(st[2 * kk + 1][2], st[2 * kk + 1][3]);
        const bf16x8 pf = __builtin_bit_cast(bf16x8, pw);
#pragma unroll
        for (int dt = 0; dt < 4; ++dt) { const LAS unsigned char* vp = L + SW_VT + (16 * (qt + 2 * kk) + 4 * gq + (fr >> 2)) * AT_RS + (16 * dt + 4 * (fr & 3)) * 2;
            const bf16x8 vf = cat8(trr(vp), trr(vp + 16 * AT_RS)); o[dt] = MFMA16(vf, pf, o[dt]); }
    }
#pragma unroll
    for (int dt = 0; dt < 4; ++dt) { u32x2 w; w.x = cvtpk(o[dt][0] * inv, o[dt][1] * inv); w.y = cvtpk(o[dt][2] * inv, o[dt][3] * inv);
        *(u32x2*)(MIX + m * DM + 512 + hq * 64 + 16 * dt + 4 * gq) = w; }
    LBAR();
}

constexpr int NA_KT = 0, NA_VT = 576 * 128, NA_RK = 2 * 576 * 128, NA_BIAS = NA_RK + 576 * 4;
static_assert(NA_BIAS + 465 * 4 <= LDSCTL_OFF, "NA LDS map");
__device__ __forceinline__ int na_off(int row, int chunk) { return row * 128 + ((chunk ^ (row & 7)) << 4); }
struct NaPre { u32x4 kv[9], vv[9], q0, q1; };
template <int PART>
__device__ __forceinline__ void na_issue(const Args& a, const Ctx& X, int unit, NaPre& P) {
    const int b = unit >> 9, rp = (unit >> 3) & 63, h = unit & 7, vr0 = __builtin_amdgcn_readfirstlane(min(max(2 * rp - 4, 0), 120));
    const bf16_t* U = (const bf16_t*)(a.ws + WS_U);
#pragma unroll
    for (int i = 0; i < 9; ++i) { const int it = X.tid + 512 * i, key = it >> 3, sub = it & 7, kr = vr0 + (key >> 6);
        if (PART == 0) P.kv[i] = (u32x4){0u, 0u, 0u, 0u}; else P.vv[i] = (u32x4){0u, 0u, 0u, 0u};
        if (kr < 128) { const bf16_t* p = U + (size_t)(b * SEQ + kr * 64 + (key & 63)) * NU + h * 64 + 8 * sub; if (PART == 0) P.kv[i] = *(const u32x4*)(p + U_NAK); else P.vv[i] = *(const u32x4*)(p + U_NAV); } }
    if (PART == 0) {
        const int qrow = 2 * rp + (X.wave >> 2), c = 16 * (X.wave & 3) + (X.lane & 15), gq = X.lane >> 4;
        const bf16_t* qp = U + (size_t)(b * SEQ + qrow * 64 + c) * NU + U_NAQ + h * 64 + 8 * gq;
        P.q0 = *(const u32x4*)qp; P.q1 = *(const u32x4*)(qp + 32); }
}
__device__ __forceinline__ void na_fast_unit(const Args& a, const Ctx& X, int l, int unit, NaPre& P, int next_unit) {
    const int b = unit >> 9, rp = (unit >> 3) & 63, h = unit & 7;
    bf16_t* MIX = (bf16_t*)(a.ws + WS_MIX);
    LAS unsigned char* L = X.lds; LAS float* BIAS = (LAS float*)(L + NA_BIAS); LAS float* RK = (LAS float*)(L + NA_RK);
    const int vr0 = __builtin_amdgcn_readfirstlane(min(max(2 * rp - 4, 0), 120));
#pragma unroll
    for (int i = 0; i < 9; ++i) { const int it = X.tid + 512 * i, key = it >> 3, sub = it & 7;
        float f[8]; unpack8(P.kv[i], f); float ss = 0.f;
#pragma unroll
        for (int e = 0; e < 8; ++e) ss += f[e] * f[e];
        ss += shx(ss, 1); ss += shx(ss, 2); ss += shx(ss, 4);
        if (sub == 0) RK[key] = rsqrtf(ss * (1.f / 64.f) + EPS);
        const int so = (X.tid >> 3) * 128 + ((sub ^ ((X.tid >> 3) & 7)) << 4) + i * 8192;
        *(LAS u32x4*)(L + NA_KT + so) = P.kv[i]; *(LAS u32x4*)(L + NA_VT + so) = P.vv[i]; }
    { const float* rpb = a.in[5] + (size_t)(l * 8 + h) * 465; if (X.tid < 465) BIAS[X.tid] = rpb[X.tid]; }
    const u32x4 qr0 = P.q0, qr1 = P.q1;
    const int fr = X.lane & 15, gq = X.lane >> 4;
    const int qrow = 2 * rp + (X.wave >> 2), cb = 16 * (X.wave & 3), r0 = __builtin_amdgcn_readfirstlane(min(max(qrow - 4, 0), 120)), wsc = __builtin_amdgcn_readfirstlane(min(max(cb - 8, 0), 32));
    const int c = cb + fr, c0 = min(max(c - 8, 0), 48);
    const size_t m = (size_t)(b * SEQ + qrow * 64 + c);
    bf16x8 qf[2];
    {
        const float* qnw = a.in[3] + l * 64; const float* knw = a.in[4] + l * 64;
        float q[2][8]; unpack8(qr0, q[0]); unpack8(qr1, q[1]);
        float ss = 0.f;
#pragma unroll
        for (int e = 0; e < 8; ++e) ss += q[0][e] * q[0][e] + q[1][e] * q[1][e];
        ss += shx(ss, 16); ss += shx(ss, 32);
        const float rstd = rsqrtf(ss * (1.f / 64.f) + EPS) * 0.125f;
#pragma unroll
        for (int ks = 0; ks < 2; ++ks) { const f32x4 w0 = *(const f32x4*)(qnw + 32 * ks + 8 * gq), w1 = *(const f32x4*)(qnw + 32 * ks + 8 * gq + 4), k0 = *(const f32x4*)(knw + 32 * ks + 8 * gq), k1 = *(const f32x4*)(knw + 32 * ks + 8 * gq + 4);
#pragma unroll
            for (int e = 0; e < 8; ++e) q[ks][e] *= rstd * (e < 4 ? w0[e & 3] * k0[e & 3] : w1[e & 3] * k1[e & 3]);
            u32x4 o; o.x = cvtpk(q[ks][0], q[ks][1]); o.y = cvtpk(q[ks][2], q[ks][3]); o.z = cvtpk(q[ks][4], q[ks][5]); o.w = cvtpk(q[ks][6], q[ks][7]); qf[ks] = __builtin_bit_cast(bf16x8, o); }
    }
    LBAR();
    if (next_unit >= 0) na_issue<0>(a, X, next_unit, P);
    int ksw[2];
#pragma unroll
    for (int ks = 0; ks < 2; ++ks) ksw[ks] = fr * 128 + (((4 * ks + gq) ^ (fr & 7)) << 4);
    f32x4 st[16]; float mx = -INFINITY;
#pragma unroll
    for (int t = 0; t < 16; ++t) { const int kr = r0 + (t >> 1), kc0 = wsc + 16 * (t & 1), keyb = (kr - vr0) * 64 + kc0;
        f32x4 s = (f32x4){0.f, 0.f, 0.f, 0.f};
#pragma unroll
        for (int ks = 0; ks < 2; ++ks) { const bf16x8 kf = *(const LAS bf16x8*)(L + NA_KT + keyb * 128 + ksw[ks]); s = MFMA16(kf, qf[ks], s); }
        const f32x4 rk = *(const LAS f32x4*)(RK + keyb + 4 * gq);
#pragma unroll
        for (int r = 0; r < 4; ++r) { const int kcol = kc0 + 4 * gq + r; const bool ok = kcol >= c0 && kcol < c0 + 16;
            const int bi = (kr - qrow + 7) * 31 + (kcol - c + 15);
            const float v = ok ? s[r] * rk[r] + BIAS[ok ? bi : 0] : -INFINITY; s[r] = v; mx = fmaxf(mx, v); }
        st[t] = s; if ((t & 3) == 3) __builtin_amdgcn_sched_barrier(0); }
    mx = fmaxf(mx, shx(mx, 16)); mx = fmaxf(mx, shx(mx, 32));
    float sum = 0.f;
#pragma unroll
    for (int t = 0; t < 16; ++t)
#pragma unroll
        for (int r = 0; r < 4; ++r) { st[t][r] = __expf(st[t][r] - mx); sum += st[t][r]; }
    sum += shx(sum, 16); sum += shx(sum, 32);
    const float inv = 1.0f / sum;
    if (next_unit >= 0) na_issue<1>(a, X, next_unit, P);
    f32x4 o[4]; int vsw[4];
#pragma unroll
    for (int dt = 0; dt < 4; ++dt) { o[dt] = (f32x4){0.f, 0.f, 0.f, 0.f}; const int rl = 4 * gq + (fr >> 2); vsw[dt] = rl * 128 + (((2 * dt + ((fr & 3) >> 1)) ^ (rl & 7)) << 4) + 8 * (fr & 1); }
#pragma unroll
    for (int kk = 0; kk < 8; ++kk) {
        u32x4 pw; pw.x = cvtpk(st[2 * kk][0], st[2 * kk][1]); pw.y = cvtpk(st[2 * kk][2], st[2 * kk][3]); pw.z = cvtpk(st[2 * kk + 1][0], st[2 * kk + 1][1]); pw.w = cvtpk(st[2 * kk + 1][2], st[2 * kk + 1][3]);
        const bf16x8 pf = __builtin_bit_cast(bf16x8, pw);
        const int rowu = ((r0 + kk - vr0) * 64 + wsc) * 128;
#pragma unroll
        for (int dt = 0; dt < 4; ++dt) { const bf16x8 vf = cat8(trr(L + NA_VT + rowu + vsw[dt]), trr(L + NA_VT + rowu + 16 * 128 + vsw[dt])); o[dt] = MFMA16(vf, pf, o[dt]); }
    }
#pragma unroll
    for (int dt = 0; dt < 4; ++dt) { u32x2 w; w.x = cvtpk(o[dt][0] * inv, o[dt][1] * inv); w.y = cvtpk(o[dt][2] * inv, o[dt][3] * inv);
        *(u32x2*)(MIX + m * DM + h * 64 + 16 * dt + 4 * gq) = w; }
    LBAR();
}

constexpr int CV_GLU = 0, CV_BLK = 94 * 1024;
__device__ __forceinline__ void conf_fast_unit(const Args& a, const Ctx& X, int l, int unit) {
    const int b = unit >> 7, t0 = 64 * (unit & 127);
    const bf16_t* U = (const bf16_t*)(a.ws + WS_U); bf16_t* MIX = (bf16_t*)(a.ws + WS_MIX);
    LAS unsigned char* L = X.lds;
    {
        u32x4 aw[12], gw_[12];
#pragma unroll
        for (int i = 0; i < 12; ++i) { const int it = X.tid + 512 * i, j = it >> 6, cg = it & 63, t = t0 - 15 + j;
            aw[i] = (u32x4){0u, 0u, 0u, 0u}; gw_[i] = (u32x4){0u, 0u, 0u, 0u};
            if (it < 94 * 64 && t >= 0 && t < SEQ) { const bf16_t* p = U + (size_t)(b * SEQ + t) * NU + 8 * cg; aw[i] = *(const u32x4*)(p + U_CA); gw_[i] = *(const u32x4*)(p + U_CG); } }
#pragma unroll
        for (int i = 0; i < 12; ++i) { const int it = X.tid + 512 * i, j = it >> 6, cg = it & 63;
            float av[8], gv[8]; unpack8(aw[i], av); unpack8(gw_[i], gv);
#pragma unroll
            for (int e = 0; e < 8; ++e) av[e] *= sigmoidf_(gv[e]);
            u32x4 o; o.x = cvtpk(av[0], av[1]); o.y = cvtpk(av[2], av[3]); o.z = cvtpk(av[4], av[5]); o.w = cvtpk(av[6], av[7]);
            if (it < 94 * 64) *(LAS u32x4*)(L + CV_GLU + j * 1024 + cg * 16) = o; }
    }
    const int c = X.tid;
    float w[31];
    { const float* dw = a.in[15] + (size_t)l * 31 * 512 + c;
#pragma unroll
      for (int k = 0; k < 31; ++k) w[k] = dw[k * 512]; }
    const float bias = a.in[16][l * 512 + c];
    const f32x4 lw0 = *(const f32x4*)(a.in[17] + l * 512 + 8 * X.lane), lw1 = *(const f32x4*)(a.in[17] + l * 512 + 8 * X.lane + 4), lb0 = *(const f32x4*)(a.in[18] + l * 512 + 8 * X.lane), lb1 = *(const f32x4*)(a.in[18] + l * 512 + 8 * X.lane + 4);
    LBAR();
#pragma unroll 1
    for (int blk = 0; blk < 8; ++blk) {
        float acc[8];
#pragma unroll
        for (int o = 0; o < 8; ++o) acc[o] = bias;
#pragma unroll
        for (int jj = 0; jj < 38; ++jj) { const float v = bf1(*(const LAS bf16_t*)(L + CV_GLU + (8 * blk + jj) * 1024 + c * 2));
#pragma unroll
            for (int o = 0; o < 8; ++o) { const int k = jj - o; if (k >= 0 && k < 31) acc[o] += w[k] * v; } }
        LAS float* BL = (LAS float*)(L + CV_BLK + (blk & 1) * 16384);
#pragma unroll
        for (int o = 0; o < 8; ++o) BL[o * 512 + c] = acc[o];
        LBAR();
        const f32x4 x0 = *(const LAS f32x4*)(BL + X.wave * 512 + 8 * X.lane), x1 = *(const LAS f32x4*)(BL + X.wave * 512 + 8 * X.lane + 4);
        float x[8] = {x0[0], x0[1], x0[2], x0[3], x1[0], x1[1], x1[2], x1[3]};
        float s = 0.f;
#pragma unroll
        for (int e = 0; e < 8; ++e) s += x[e];
        const float mu = wsum(s) * (1.f / 512.f); float q = 0.f;
#pragma unroll
        for (int e = 0; e < 8; ++e) { x[e] -= mu; q += x[e] * x[e]; }
        const float rstd = rsqrtf(wsum(q) * (1.f / 512.f) + EPS);
        float y[8];
#pragma unroll
        for (int e = 0; e < 8; ++e) y[e] = siluf_(x[e] * rstd * (e < 4 ? lw0[e & 3] : lw1[e & 3]) + (e < 4 ? lb0[e & 3] : lb1[e & 3]));
        u32x4 ow; ow.x = cvtpk(y[0], y[1]); ow.y = cvtpk(y[2], y[3]); ow.z = cvtpk(y[4], y[5]); ow.w = cvtpk(y[6], y[7]);
        *(u32x4*)(MIX + (size_t)(b * SEQ + t0 + 8 * blk + X.wave) * DM + 1536 + 8 * X.lane) = ow;
    }
    LBAR();
}

#ifndef FAST_CONF
#define FAST_CONF 0
#endif
__device__ __forceinline__ void phase_mix_swa(const Args& a, const Ctx& X, int l) {
#if FAST_SWA
    SwaPre P; if (X.bid < 1024) swa_issue(a, X, X.bid, P);
#pragma unroll 1
    for (int un = X.bid; un < 1024; un += X.G) swa_fast_unit(a, X, l, un, P, un + X.G < 1024 ? un + X.G : -1);
#else
    LAS float* sc = (LAS float*)(X.lds + X.wave * 2048);
    for (int it = X.gw; it < T * 8; it += X.NGW) swa_slow_item(a, l, it >> 3, it & 7, sc, X.lane);
#endif
}
__device__ __forceinline__ void phase_mix_na(const Args& a, const Ctx& X, int l) {
#if FAST_NA
    NaPre P; if (X.bid < 1024) { na_issue<0>(a, X, X.bid, P); na_issue<1>(a, X, X.bid, P); }
#pragma unroll 1
    for (int un = X.bid; un < 1024; un += X.G) na_fast_unit(a, X, l, un, P, un + X.G < 1024 ? un + X.G : -1);
#else
    LAS float* sc = (LAS float*)(X.lds + X.wave * 2048);
    for (int it = X.gw; it < T * 8; it += X.NGW) na_slow_item(a, l, it >> 3, it & 7, sc, X.lane);
#endif
}
__device__ __forceinline__ void phase_mix_conf(const Args& a, const Ctx& X, int l) {
#if FAST_CONF
#pragma unroll 1
    for (int un = X.bid; un < 256; un += X.G) conf_fast_unit(a, X, l, un);
#else
    for (int it = X.gw; it < T; it += X.NGW) conf_slow_item(a, l, it, X.lane);
#endif
}
constexpr int PPL = 10;
constexpr int NPHASE = 1 + DEPTH * PPL + 1;

__global__ void __launch_bounds__(512, 2) fwd(Args args) {
    extern __shared__ __attribute__((aligned(16))) unsigned char lds_[];
    Ctx X;
#define MKCTX() do { int t_ = threadIdx.x; asm volatile("" : "+v"(t_)); X.lds = (LAS unsigned char*)lds_; X.tid = t_; X.lane = t_ & 63; X.wave = __builtin_amdgcn_readfirstlane(t_ >> 6); \
        int b_ = blockIdx.x; asm volatile("" : "+s"(b_)); X.G = gridDim.x; X.bid = b_; X.gw = X.bid * 8 + X.wave; X.NGW = X.G * 8; } while (0)
    MKCTX();
    volatile LAS unsigned* MISC = (volatile LAS unsigned*)(X.lds + MISC_OFF);
    for (int u = X.tid; u < 256; u += 512) ((LAS unsigned*)(X.lds + LDSCTL_OFF))[u] = 0u;
    __syncthreads();
    unsigned* barw = (unsigned*)(args.ws + WS_CTL) + CW_BAR;
    XcdBarrier bar; bar.bar = barw; bar.x = 0; bar.st = nullptr;
    if (!args.multi) bar = xcd_barrier_post(barw, MISC + 8);
    const int lo = args.ph_lo, hi = args.ph_hi;
#ifndef PROBE_PRE
#define PROBE_PRE 0
#endif
#ifndef RT_MFMA
#define RT_MFMA 1
#endif
#ifndef PROBE_OUTZ
#define PROBE_OUTZ 0
#endif
#ifndef PROBE_OUT
#define PROBE_OUT 0
#endif
#ifndef PROBE_GUCOLD
#define PROBE_GUCOLD 0
#endif
#ifndef SPLITSEAM
#define SPLITSEAM 0
#endif
#ifndef TOPK_IN_GU
#define TOPK_IN_GU 0
#endif
#ifndef TOPK_HANDOFF
#define TOPK_HANDOFF 0
#endif
#ifndef WAUX
#define WAUX 0
#endif
#ifndef PHMASK
#define PHMASK 0xfffff
#endif
#define IN(k) (lo <= (k) && (k) < hi)
#define EN(j) ((PHMASK >> (j)) & 1)
#ifndef REPMASK
#define REPMASK 0
#endif
#define REP(j) _Pragma("unroll 1") for (int rep_ = 0; rep_ < ((REPMASK >> (j)) & 1) + 1; ++rep_)
#ifndef BARREP
#define BARREP 1
#endif
#define SEAM(k) do { if ((k) + 1 < hi) { _Pragma("unroll 1") for (int br_ = 0; br_ < BARREP; ++br_) xcd_barrier(bar); } } while (0)
    const Args& a = args;
    LAS unsigned char* ring = X.lds;
    const LAS int* rmapL = (const LAS int*)(X.lds + RMAPL_OFF);

    if (EN(0) && IN(0)) { REP(0) { MKCTX(); phase_prologue(a, X); } MKCTX(); phase_pre(a, X, 0);
        if (!a.multi && X.wave == 0) xcd_barrier_census_wave(bar, lane_opq());
        SEAM(0); }

    for (int l = 0; l < DEPTH; ++l) {
        const int pb = 1 + l * PPL;
#if PROBE_PRE
        if (EN(1) && IN(pb + 0)) { MKCTX(); phase_pre(a, X, l, true); __syncthreads(); }
#endif
        if (EN(1) && IN(pb + 0) && l > 0) { MKCTX(); phase_pre(a, X, l); SEAM(pb + 0); }
        if (EN(2) && IN(pb + 1)) { REP(2) { MKCTX();
            pg8::Gemm g{(const bf16_t*)(a.ws + WS_XR), (const bf16_t*)(a.ws + WS_WIN) + (size_t)l * NU * DM, DM};
            pg8::StaticOrder S; S.init(T, NU, X.G, X.bid, 0);
            { const float* RS1 = (const float*)(a.ws + WS_RSTD1); LAS float* rs = (LAS float*)(X.lds + RSTDL_OFF);
              bool ok[8]; int pmv[8]; float rv[8];
#pragma unroll
              for (int ui = 0; ui < 8; ++ui) { pg8::Unit u; ok[ui] = S.next(ui, u); pmv[ui] = ok[ui] ? u.pm : 0; }
#pragma unroll
              for (int ui = 0; ui < 8; ++ui) rv[ui] = RS1[pmv[ui] * 256 + (X.tid & 255)];
#pragma unroll
              for (int ui = 0; ui < 8; ++ui) if (ok[ui] && X.tid < 256) rs[ui * 256 + X.tid] = rv[ui];
              __syncthreads(); }
            pg8::EpiU E{(bf16_t*)(a.ws + WS_U), (float*)(a.ws + WS_DTRAW), (const LAS float*)(X.lds + RSTDL_OFF)};
            pg8::gemm_phase<pg8::EpiU, pg8::StaticOrder, false>(ring, g, S, E, rmapL); }
            SEAM(pb + 1);
        }
#if FAST_SSD
        if (EN(3) && IN(pb + 2)) { REP(3) {
#ifndef SUBMASK
#define SUBMASK 15
#endif
            const bool s1_first = ((blockIdx.x >> 3) & 1) == 0;
            if ((SUBMASK & 1) && s1_first) REP(12) { MKCTX();
#pragma unroll 1
                for (int un = X.bid; un < 256; un += X.G) ssd_s1_unit(a, X, l, un);
                __syncthreads(); }
            const int ccls = (blockIdx.x >> 4) & 3; const bool cnext = LAZY_CONVERT && (JIT_CONVERT || l + 1 < DEPTH);
            if (cnext && ccls == 0) { MKCTX(); if (JIT_CONVERT) convert_jit(a, X, l); else convert_layer_weights(a, X, l + 1); __syncthreads(); }
            if (SUBMASK & 2) REP(13) { MKCTX(); phase_mix_swa(a, X, l); __syncthreads(); }
            if (cnext && ccls == 1) { MKCTX(); if (JIT_CONVERT) convert_jit(a, X, l); else convert_layer_weights(a, X, l + 1); __syncthreads(); }
            if (SUBMASK & 4) REP(14) { MKCTX(); phase_mix_na(a, X, l); __syncthreads(); }
            if (cnext && ccls == 2) { MKCTX(); if (JIT_CONVERT) convert_jit(a, X, l); else convert_layer_weights(a, X, l + 1); __syncthreads(); }
            if (SUBMASK & 8) REP(15) { MKCTX(); phase_mix_conf(a, X, l); __syncthreads(); }
            if (cnext && ccls == 3) { MKCTX(); if (JIT_CONVERT) convert_jit(a, X, l); else convert_layer_weights(a, X, l + 1); __syncthreads(); }
            if ((SUBMASK & 1) && !s1_first) { MKCTX();
#pragma unroll 1
                for (int un = X.bid; un < 256; un += X.G) ssd_s1_unit(a, X, l, un);
                __syncthreads(); } }
            SEAM(pb + 2); }
        if (EN(4) && IN(pb + 3)) { REP(4) { MKCTX(); phase_ssd_scan(a, X); } SEAM(pb + 3); }
        if (EN(5) && IN(pb + 4)) { REP(5) { MKCTX();
#pragma unroll 1
            for (int un = X.bid; un < 256; un += X.G) ssd_s3_unit(a, X, l, un); }
            SEAM(pb + 4); }
#else
        if (EN(3) && IN(pb + 2)) { MKCTX(); phase_ssd_prep(a, X, l); SEAM(pb + 2); }
        if (EN(4) && IN(pb + 3)) { MKCTX(); if (X.bid < 32) ssd_slow_unit(a, l, X.bid, X.tid); else { X.bid -= 32; X.G -= 32; X.gw = X.bid * 8 + X.wave; X.NGW = X.G * 8; phase_mix_swa(a, X, l); phase_mix_na(a, X, l); phase_mix_conf(a, X, l); } SEAM(pb + 3); }
        if (EN(5) && IN(pb + 4)) { MKCTX(); phase_ssd_fin_slow(a, X, l); SEAM(pb + 4); }
#endif
#if PROBE_OUT
        if (EN(6) && IN(pb + 5)) { MKCTX();
            pg8::Gemm g{(const bf16_t*)(a.ws + WS_MIX), (const bf16_t*)(a.ws + WS_WOUT) + (size_t)l * DM * DM, DM};
            pg8::StaticOrder S; S.init(T, DM, X.G, X.bid, 0);
            pg8::EpiRes E{(bf16_t*)(a.ws + WS_Y)};
            pg8::gemm_phase<pg8::EpiRes, pg8::StaticOrder, false>(ring, g, S, E, rmapL);
        }
#endif
        if (EN(6) && IN(pb + 5)) { MKCTX();
#if PROBE_OUTZ
            volatile LAS int* rc_ = (volatile LAS int*)(X.lds + MISC_OFF + 64);
            if (X.tid == 0) rc_[0] = 0;
            __syncthreads();
#pragma unroll 1
            for (;;) {
                const int r_ = __builtin_amdgcn_readfirstlane(rc_[0]);
                pg8::Gemm g{(const bf16_t*)(a.ws + WS_MIX), r_ == 0 ? (const bf16_t*)(a.ws + WS_END) : (const bf16_t*)(a.ws + WS_WOUT) + (size_t)l * DM * DM, DM};
                pg8::StaticOrder S; S.init(T, DM, X.G, X.bid, 0);
                pg8::EpiRes E{(bf16_t*)(a.ws + WS_XR)};
                pg8::gemm_phase<pg8::EpiRes, pg8::StaticOrder, false>(ring, g, S, E, rmapL);
                __syncthreads();
                if (r_ != 0) break;
                if (X.tid == 0) rc_[0] = 1;
                asm volatile("s_waitcnt vmcnt(0)" ::: "memory");
                __syncthreads();
            }
#else
            pg8::Gemm g{(const bf16_t*)(a.ws + WS_MIX), (const bf16_t*)(a.ws + WS_WOUT) + (size_t)l * DM * DM, DM};
            pg8::StaticOrder S; S.init(T, DM, X.G, X.bid, 0);
            pg8::EpiRes E{(bf16_t*)(a.ws + WS_XR)};
            pg8::gemm_phase<pg8::EpiRes, pg8::StaticOrder, false>(ring, g, S, E, rmapL);
#endif
            SEAM(pb + 5);
        }
#if TOPK_HANDOFF
        unsigned* cnt_rt = (unsigned*)(a.ws + WS_CTL) + 8192 + l * 128; unsigned* cnt_tk = cnt_rt + 64; unsigned* tmo_w = barw + XB_TMO;
        if (EN(7) && IN(pb + 6)) { MKCTX(); phase_router(a, X, l); wg_arrive(cnt_rt);
            if (X.bid < NB * NEXP) { wg_wait(cnt_rt, (unsigned)X.G, tmo_w); MKCTX(); phase_topk(a, X); wg_arrive(cnt_tk); } }
#else
        if (EN(7) && IN(pb + 6)) { REP(7) { MKCTX(); if (RT_MFMA) phase_router_mfma(a, X, l); else phase_router(a, X, l); } SEAM(pb + 6); }
#if !TOPK_IN_GU
        if (EN(8) && IN(pb + 7)) { REP(8) { MKCTX(); phase_topk(a, X); if (LAZY_CONVERT && JIT_CONVERT && l + 1 < DEPTH) convert_in_topk(a, X, l); __syncthreads(); } SEAM(pb + 7); }
#endif
#endif
        if (EN(9) && IN(pb + 8)) { REP(9) { MKCTX();
            pg8::Gemm g{(const bf16_t*)(a.ws + WS_XR), (const bf16_t*)(a.ws + WS_WGU) + (size_t)l * NEXP * 2048 * DM, DM};
            pg8::StaticOrder S; S.init(NSLOT, 2048, X.G, X.bid, 8);
#if TOPK_HANDOFF
            wg_wait(cnt_tk, (unsigned)(NB * NEXP), tmo_w);
#endif
#if TOPK_IN_GU
            { LAS int* rl = (LAS int*)(X.lds + RMAPL_OFF); pg8::Unit u; int ui = 0;
              while (ui < 8 && S.next(ui, u)) { const int pm = u.pm; int n = 1; pg8::Unit u2; bool pn0 = (u.pn == 0);
                  while (ui + n < 8 && S.next(ui + n, u2) && u2.pm == pm) { pn0 = pn0 || (u2.pn == 0); ++n; }
                  const bool pub = ((pm & 3) == 0) && pn0;
                  topk_run(a, X, ((pm >> 2) & 1) * 16 + (pm >> 3), pub, rl + ui * 256, n, (pm & 3) * 256);
                  for (int q = 2; q < n; ++q) { if (X.tid < 256) rl[(ui + q) * 256 + X.tid] = rl[ui * 256 + X.tid]; }
                  ui += n; }
              __syncthreads(); }
#else
            { const int* RMAP = (const int*)(a.ws + WS_RMAP); LAS int* rl = (LAS int*)(X.lds + RMAPL_OFF);
              const float* RSTD = (const float*)(a.ws + WS_RSTD); LAS float* rs = (LAS float*)(X.lds + RSTDL_OFF);
              bool ok[8]; int pmv[8], tok[8]; float rv[8];
#pragma unroll
              for (int ui = 0; ui < 8; ++ui) { pg8::Unit u; ok[ui] = S.next(ui, u); pmv[ui] = ok[ui] ? u.pm : 0; }
#pragma unroll
              for (int ui = 0; ui < 8; ++ui) tok[ui] = RMAP[pmv[ui] * 256 + (X.tid & 255)];
#pragma unroll
              for (int ui = 0; ui < 8; ++ui) rv[ui] = RSTD[tok[ui]];
#pragma unroll
              for (int ui = 0; ui < 8; ++ui) if (ok[ui] && X.tid < 256) { rl[ui * 256 + X.tid] = tok[ui]; rs[ui * 256 + X.tid] = rv[ui]; }
              __syncthreads(); }
#endif
            pg8::EpiSwiglu E{(bf16_t*)(a.ws + WS_HID), (const LAS float*)(X.lds + RSTDL_OFF)};
            pg8::gemm_phase<pg8::EpiSwiglu, pg8::StaticOrder, true, WAUX>(ring, g, S, E, rmapL); }
            SEAM(pb + 8);
        }
#if PROBE_GUCOLD
        if (EN(9) && IN(pb + 8)) { MKCTX();
            pg8::Gemm g{(const bf16_t*)(a.ws + WS_HN), (const bf16_t*)(a.ws + WS_WGU) + (size_t)((l + 1) & 3) * NEXP * 2048 * DM, DM};
            pg8::StaticOrder S; S.init(NSLOT, 2048, X.G, X.bid, 8);
            pg8::EpiSwiglu E{(bf16_t*)(a.ws + WS_END)};
            pg8::gemm_phase<pg8::EpiSwiglu, pg8::StaticOrder, true>(ring, g, S, E, rmapL);
        }
#endif
        if (EN(10) && IN(pb + 9)) { REP(10) { MKCTX();
            pg8::Gemm g{(const bf16_t*)(a.ws + WS_HID), (const bf16_t*)(a.ws + WS_WDN) + (size_t)l * NEXP * 2048 * FF, FF};
            pg8::StaticOrder S; S.init(NSLOT, 2048, X.G, X.bid, 8);
            pg8::EpiDown E{(bf16_t*)(a.ws + WS_Y), (const float*)(a.ws + WS_GATE)};
            pg8::gemm_phase<pg8::EpiDown, pg8::StaticOrder, false, WAUX>(ring, g, S, E, rmapL); }
            SEAM(pb + 9);
        }
    }
    if (EN(11) && IN(1 + DEPTH * PPL)) { MKCTX(); phase_pre(a, X, DEPTH); }
#undef IN
#undef SEAM
}

extern "C" void kernel_launch(void* const* d_in, const int* in_sizes, int n_in, void* d_out, int out_size, void* d_ws, size_t ws_size, hipStream_t stream) {
    static int grid = 0;
    if (grid == 0) {
        if (n_in != 25 || in_sizes[0] != T * DM || out_size != T * DM || ws_size < WS_END + PROBE_GUCOLD * 64 * MiB) { fprintf(stderr, "kernel_launch: unexpected shapes (n_in %d, in0 %d, out %d, ws %zu < %zu); nothing launched\n", n_in, n_in > 0 ? in_sizes[0] : -1, out_size, ws_size, (size_t)WS_END); grid = -1; return; }
        int dev = 0, cus = 0, per_cu = 0;
        if (hipGetDevice(&dev) != hipSuccess || hipDeviceGetAttribute(&cus, hipDeviceAttributeMultiprocessorCount, dev) != hipSuccess) { grid = -1; return; }
        if (hipFuncSetAttribute((const void*)fwd, hipFuncAttributeMaxDynamicSharedMemorySize, LDS_BYTES) != hipSuccess) { fprintf(stderr, "kernel_launch: hipFuncSetAttribute failed\n"); grid = -1; return; }
        if (hipOccupancyMaxActiveBlocksPerMultiprocessor(&per_cu, (const void*)fwd, 512, LDS_BYTES) != hipSuccess || per_cu < 1) { fprintf(stderr, "kernel_launch: occupancy query reports %d blocks per CU\n", per_cu); }
        (void)hipGetLastError();
        grid = cus;
        if (grid < 128) { fprintf(stderr, "kernel_launch: needs >= 128 CUs\n"); grid = -1; return; }
    }
    if (grid < 0) return;
    if (hipMemsetAsync((char*)d_ws + WS_CTL, 0, CTL_ZERO_BYTES, stream) != hipSuccess) return;
#if PROBE_OUTZ
    if (hipMemsetAsync((char*)d_ws + WS_END, 0, (size_t)DM * DM * 2, stream) != hipSuccess) return;
#endif
    Args a{};
    for (int i = 0; i < 25; ++i) a.in[i] = (const float*)d_in[i];
    a.out = (float*)d_out; a.ws = (unsigned char*)d_ws; a.pad = 0;
#if MK_MULTI
    for (int p = 0; p < NPHASE; ++p) { a.ph_lo = p; a.ph_hi = p + 1; a.multi = 1; hipLaunchKernelGGL(fwd, dim3(grid), dim3(512), LDS_BYTES, stream, a); }
#else
    a.ph_lo = 0; a.ph_hi = NPHASE; a.multi = 0;
    hipLaunchKernelGGL(fwd, dim3(grid), dim3(512), LDS_BYTES, stream, a);
#endif
}
```

```cpp
#define FAST_CONF 1
#define FAST_NA 1
#define FAST_SWA 1
#define FAST_SSD 1
#include <hip/hip_runtime.h>
#include <cstdio>
#include <cstdint>

#ifndef MK_MULTI
#define MK_MULTI 0
#endif
#ifndef FAST_SSD
#define FAST_SSD 0
#endif
#ifndef FAST_SWA
#define FAST_SWA 0
#endif
#ifndef FAST_NA
#define FAST_NA 0
#endif

#define GAS __attribute__((address_space(1)))
#define LAS __attribute__((address_space(3)))
typedef unsigned short bf16_t;
typedef short bf16x8 __attribute__((ext_vector_type(8)));
typedef float f32x4 __attribute__((ext_vector_type(4)));
typedef float f32x2 __attribute__((ext_vector_type(2)));
typedef unsigned u32x4 __attribute__((ext_vector_type(4)));
typedef unsigned u32x2 __attribute__((ext_vector_type(2)));
typedef __bf16 bf16x2_t __attribute__((ext_vector_type(2)));
typedef GAS unsigned gu32;

constexpr int SEQ = 8192, NB = 2, T = NB * SEQ, DM = 2048, DEPTH = 4;
constexpr int INW = 4880;
constexpr int NU = 5120;
constexpr int U_NAQ = 0, U_NAK = 512, U_NAV = 1024, U_WAQ = 1536, U_WAK = 2048, U_WAV = 2176, U_Z = 2304, U_XBC = 2816, U_CA = 3840, U_CG = 4352, U_DT = 4864;
constexpr int NEXP = 16, CAP = 1024, FF = 1024, NSLOT = NB * NEXP * CAP;
constexpr float EPS = 1e-6f;

constexpr size_t MiB = 1u << 20;
constexpr size_t WS_CTL = 0, CTL_ZERO_BYTES = 64 * 1024;
constexpr size_t WS_WIN = 2 * MiB;
constexpr size_t WS_WOUT = WS_WIN + 80 * MiB;
constexpr size_t WS_WGU = WS_WOUT + 32 * MiB;
constexpr size_t WS_WDN = WS_WGU + 512 * MiB;
constexpr size_t WS_HN = WS_WDN + 256 * MiB;
constexpr size_t WS_U = WS_HN + 64 * MiB;
constexpr size_t WS_MIX = WS_U + 160 * MiB;
constexpr size_t WS_HID = WS_MIX + 64 * MiB;
constexpr size_t WS_Y = WS_HID + 64 * MiB;
constexpr size_t WS_XBC = WS_Y + 128 * MiB;
constexpr size_t WS_YSSD = WS_XBC + 64 * MiB;
constexpr size_t WS_STATE = WS_YSSD + 64 * MiB;
constexpr size_t WS_DTRAW = WS_STATE + 64 * MiB;
constexpr size_t WS_DT = WS_DTRAW + 1 * MiB;
constexpr size_t WS_AFF = WS_DT + 1 * MiB;
constexpr size_t WS_SEL = WS_AFF + 1 * MiB;
constexpr size_t WS_RMAP = WS_SEL + 1 * MiB;
constexpr size_t WS_GATE = WS_RMAP + 1 * MiB;
constexpr size_t WS_ROPE = WS_GATE + 1 * MiB;
constexpr size_t WS_CDEC = WS_ROPE + 1 * MiB;
constexpr size_t WS_PREV = WS_CDEC + 1 * MiB;
constexpr size_t WS_XR = WS_PREV + 32 * MiB;
constexpr size_t WS_RSTD = WS_XR + 64 * MiB;
constexpr size_t WS_RSTD1 = WS_RSTD + 1 * MiB;
constexpr size_t WS_RTW = WS_RSTD1 + 1 * MiB;
constexpr size_t WS_END = WS_RTW + 1 * MiB;

constexpr int CW_BAR = 4096;

constexpr int RING_BYTES = 131072;
constexpr int LDS_BYTES = 163840;
constexpr int LDSCTL_OFF = LDS_BYTES - 1024;
constexpr int MISC_OFF = LDSCTL_OFF + 320;
constexpr int RMAPL_OFF = LDSCTL_OFF - 8192;
constexpr int RSTDL_OFF = RMAPL_OFF - 8192;
static_assert(RSTDL_OFF >= RING_BYTES && RMAPL_OFF >= RING_BYTES && MISC_OFF + 128 <= LDS_BYTES, "LDS map");

__device__ __forceinline__ int lane_opq() { int l; asm volatile("v_mbcnt_lo_u32_b32 %0, -1, 0\n\tv_mbcnt_hi_u32_b32 %0, -1, %0" : "=v"(l)); return l; }
__device__ __forceinline__ float shx(float v, int m) { return __int_as_float(__builtin_amdgcn_ds_bpermute((lane_opq() ^ m) << 2, __float_as_int(v))); }
__device__ __forceinline__ int shup_i(int v, int o) { const int l = lane_opq(); return __builtin_amdgcn_ds_bpermute((l >= o ? l - o : l) << 2, v); }
__device__ __forceinline__ int shdn_i(int v, int o) { const int l = lane_opq(); return __builtin_amdgcn_ds_bpermute((l + o < 64 ? l + o : l) << 2, v); }
__device__ __forceinline__ float shup_f(float v, int o) { return __int_as_float(shup_i(__float_as_int(v), o)); }
__device__ __forceinline__ int shl_i(int v, int src) { return __builtin_amdgcn_readlane(v, __builtin_amdgcn_readfirstlane(src)); }
__device__ __forceinline__ float shl_f(float v, int src) { return __int_as_float(__builtin_amdgcn_readlane(__float_as_int(v), __builtin_amdgcn_readfirstlane(src))); }
#define LBAR() asm volatile("s_waitcnt lgkmcnt(0)\n\ts_barrier" ::: "memory")
__device__ __forceinline__ unsigned cvtpk(float lo, float hi) { f32x2 v = {lo, hi}; bf16x2_t b = __builtin_convertvector(v, bf16x2_t); return __builtin_bit_cast(unsigned, b); }
__device__ __forceinline__ float bflo(unsigned w) { return __uint_as_float(w << 16); }
__device__ __forceinline__ float bfhi(unsigned w) { return __uint_as_float(w & 0xffff0000u); }
__device__ __forceinline__ float bf1(bf16_t h) { return __uint_as_float(((unsigned)h) << 16); }
__device__ __forceinline__ float wsum(float v) {
    { const int l = lane_opq();
#pragma unroll
      for (int o = 1; o < 64; o <<= 1) v += __int_as_float(__builtin_amdgcn_ds_bpermute((l ^ o) << 2, __float_as_int(v))); }
    return v;
}
__device__ __forceinline__ float wmax(float v) {
    { const int l = lane_opq();
#pragma unroll
      for (int o = 1; o < 64; o <<= 1) v = fmaxf(v, __int_as_float(__builtin_amdgcn_ds_bpermute((l ^ o) << 2, __float_as_int(v)))); }
    return v;
}
__device__ __forceinline__ float sigmoidf_(float x) { return __builtin_amdgcn_rcpf(1.0f + __expf(-x)); }
__device__ __forceinline__ float siluf_(float x) { return x * __builtin_amdgcn_rcpf(1.0f + __expf(-x)); }
__device__ __forceinline__ float softplusf_(float x) {
    if (x > 20.f) return x;
    const float e = __expf(x);
    if (e < 0.01f) return e * (1.0f - e * (0.5f - e * (1.0f / 3.0f)));
    return __logf(1.0f + e);
}
__device__ __forceinline__ void unpack8(const u32x4 w, float (&f)[8]) {
    f[0] = bflo(w.x); f[1] = bfhi(w.x); f[2] = bflo(w.y); f[3] = bfhi(w.y); f[4] = bflo(w.z); f[5] = bfhi(w.z); f[6] = bflo(w.w); f[7] = bfhi(w.w);
}

struct Args { const float* in[25]; float* out; unsigned char* ws; int ph_lo, ph_hi, multi, pad; };
namespace pg8 {
#define PG8_LAS __attribute__((address_space(3)))
constexpr int BM = 256, BK = 64, HALF = 128, HTB = HALF * BK * 2  , STAGE_BYTES = 8 * HTB, NXCD = 8, WGM = 8;

__host__ __device__ __forceinline__ int lds_byte(int r, int c) { const int st = (r >> 4) * 2 + (c >> 5), rr = r & 15, cc = c & 31, ob = rr * 64 + cc * 2; return st * 1024 + (ob ^ (((ob >> 9) & 1) << 5)); }
__host__ __device__ __forceinline__ void stage_rc(int b, int& R, int& C) { const int st = b / 1024, sb = b % 1024, swz = sb ^ (((sb >> 9) & 1) << 5); R = (st >> 1) * 16 + swz / 64; C = (st & 1) * 32 + (swz % 64) / 2; }
__host__ __device__ __forceinline__ int perm32(int rho) { const int n = rho >> 4, i = rho & 15; return 8 * (i >> 2) + 4 * n + (i & 3); }

#ifndef EPI_SC1
#define EPI_SC1 0
#endif
__device__ __forceinline__ void st16(void* p, u32x4 w) {
#if EPI_SC1
    asm volatile("global_store_dwordx4 %0, %1, off sc1" :: "v"(p), "v"(w) : "memory");
#else
    *(u32x4*)p = w;
#endif
}
struct Unit { int pm, pn, pb; };
struct Gemm { const bf16_t* A; const bf16_t* Bt; int K; };

struct StaticOrder {
    int nM, nN, nwg, G, c, nbe;
    __host__ __device__ __forceinline__ void init(int M, int N, int G_, int c_, int nbe_) { nM = M / BM; nN = N / BM; nwg = nM * nN; G = G_; c = c_; nbe = nbe_; }
    __host__ __device__ __forceinline__ bool next(int i, Unit& u) const {
        const long L = (long)i * G + c; if (L >= nwg) return false;
        int wgid = (int)L; { const int q = nwg / NXCD, r = nwg % NXCD, xcd = wgid % NXCD, off = wgid / NXCD; wgid = (xcd < r ? xcd * (q + 1) : r * (q + 1) + (xcd - r) * q) + off; }
        const int nig = WGM * nN, gid = wgid / nig, fm = gid * WGM, gsz = (nM - fm) < WGM ? (nM - fm) : WGM;
        u.pm = fm + ((wgid % nig) % gsz); u.pn = (wgid % nig) / gsz; u.pb = nbe ? (u.pm >> 3) * nbe + u.pn : u.pn; return true;
    }
};

struct EpiU {
    static constexpr bool INIT = false;
    bf16_t* U; float* dtraw; const PG8_LAS float* rs;
    __device__ __forceinline__ void operator()(const f32x4 (&acc)[2][2][4][2], const Unit& u, int wr, int wc, int fr, int fq, int ui) const {
        const int row0 = u.pm * BM + wr * 64 + fr;
        if (u.pn == 19) {
            if (wc == 0 && fq < 2) {
#pragma unroll
                for (int ai = 0; ai < 2; ++ai)
#pragma unroll
                    for (int m = 0; m < 4; ++m) { const float rsv = rs[ui * BM + wr * 64 + fr + ai * HALF + m * 16]; float* p = dtraw + (size_t)(row0 + ai * HALF + m * 16) * 16 + 8 * fq; *(f32x4*)p = acc[ai][0][m][0] * rsv; *(f32x4*)(p + 4) = acc[ai][0][m][1] * rsv; }
            }
            return;
        }
        const int col0 = u.pn * BM + wc * 32 + 8 * fq;
#pragma unroll
        for (int ai = 0; ai < 2; ++ai)
#pragma unroll
            for (int m = 0; m < 4; ++m) { const float rsv = rs[ui * BM + wr * 64 + fr + ai * HALF + m * 16]; bf16_t* rowp = U + (size_t)(row0 + ai * HALF + m * 16) * NU + col0;
#pragma unroll
                for (int bj = 0; bj < 2; ++bj) { const f32x4 v0 = acc[ai][bj][m][0] * rsv, v1 = acc[ai][bj][m][1] * rsv;
                    u32x4 w; w.x = cvtpk(v0[0], v0[1]); w.y = cvtpk(v0[2], v0[3]); w.z = cvtpk(v1[0], v1[1]); w.w = cvtpk(v1[2], v1[3]);
                    st16(rowp + bj * HALF, w); } }
    }
};
struct EpiRes {
    static constexpr bool INIT = true;
    bf16_t* XR;
    __device__ __forceinline__ void init(f32x4 (&acc)[2][2][4][2], const Unit& u, int wr, int wc, int fr, int fq) const {
        const int row0 = u.pm * BM + wr * 64 + fr, col0 = u.pn * BM + wc * 32 + 8 * fq;
        u32x4 r[2][4][2];
#pragma unroll
        for (int ai = 0; ai < 2; ++ai)
#pragma unroll
            for (int m = 0; m < 4; ++m)
#pragma unroll
                for (int bj = 0; bj < 2; ++bj) r[ai][m][bj] = *(const u32x4*)(XR + (size_t)(row0 + ai * HALF + m * 16) * DM + col0 + bj * HALF);
#pragma unroll
        for (int ai = 0; ai < 2; ++ai)
#pragma unroll
            for (int m = 0; m < 4; ++m)
#pragma unroll
                for (int bj = 0; bj < 2; ++bj) { const u32x4 w = r[ai][m][bj]; acc[ai][bj][m][0] = (f32x4){bflo(w.x), bfhi(w.x), bflo(w.y), bfhi(w.y)}; acc[ai][bj][m][1] = (f32x4){bflo(w.z), bfhi(w.z), bflo(w.w), bfhi(w.w)}; }
    }
    __device__ __forceinline__ void operator()(const f32x4 (&acc)[2][2][4][2], const Unit& u, int wr, int wc, int fr, int fq, int ui) const {
        const int row0 = u.pm * BM + wr * 64 + fr, col0 = u.pn * BM + wc * 32 + 8 * fq;
        u32x4 r[2][4][2];
        if (ui != 0) {
#pragma unroll
            for (int ai = 0; ai < 2; ++ai)
#pragma unroll
                for (int m = 0; m < 4; ++m)
#pragma unroll
                    for (int bj = 0; bj < 2; ++bj) r[ai][m][bj] = *(const u32x4*)(XR + (size_t)(row0 + ai * HALF + m * 16) * DM + col0 + bj * HALF);
        }
#pragma unroll
        for (int ai = 0; ai < 2; ++ai)
#pragma unroll
            for (int m = 0; m < 4; ++m)
#pragma unroll
                for (int bj = 0; bj < 2; ++bj) { f32x4 v0 = acc[ai][bj][m][0], v1 = acc[ai][bj][m][1];
                    if (ui != 0) { const u32x4 w = r[ai][m][bj]; v0 += (f32x4){bflo(w.x), bfhi(w.x), bflo(w.y), bfhi(w.y)}; v1 += (f32x4){bflo(w.z), bfhi(w.z), bflo(w.w), bfhi(w.w)}; }
                    u32x4 o; o.x = cvtpk(v0[0], v0[1]); o.y = cvtpk(v0[2], v0[3]); o.z = cvtpk(v1[0], v1[1]); o.w = cvtpk(v1[2], v1[3]);
                    *(u32x4*)(XR + (size_t)(row0 + ai * HALF + m * 16) * DM + col0 + bj * HALF) = o; }
    }
};
struct EpiSwiglu {
    static constexpr bool INIT = false;
    bf16_t* H; const PG8_LAS float* rs;
    __device__ __forceinline__ void operator()(const f32x4 (&acc)[2][2][4][2], const Unit& u, int wr, int wc, int fr, int fq, int ui) const {
        const int row0 = u.pm * BM + wr * 64 + fr, col0 = u.pn * HALF + wc * 32 + 8 * fq;
#pragma unroll
        for (int ai = 0; ai < 2; ++ai)
#pragma unroll
            for (int m = 0; m < 4; ++m) { bf16_t* rowp = H + (size_t)(row0 + ai * HALF + m * 16) * FF + col0;
                const float rsv = rs[ui * BM + wr * 64 + fr + ai * HALF + m * 16];
                float h[8];
#pragma unroll
                for (int n = 0; n < 2; ++n)
#pragma unroll
                    for (int j = 0; j < 4; ++j) { const float g = acc[ai][0][m][n][j] * rsv, up = acc[ai][1][m][n][j] * rsv; h[n * 4 + j] = g * __builtin_amdgcn_rcpf(1.0f + __expf(-g)) * up; }
                u32x4 w; w.x = cvtpk(h[0], h[1]); w.y = cvtpk(h[2], h[3]); w.z = cvtpk(h[4], h[5]); w.w = cvtpk(h[6], h[7]);
                st16(rowp, w); }
    }
};
struct EpiDown {
    static constexpr bool INIT = false;
    bf16_t* Y; const float* gate;
    __device__ __forceinline__ void operator()(const f32x4 (&acc)[2][2][4][2], const Unit& u, int wr, int wc, int fr, int fq, int ui) const {
        const int row0 = u.pm * BM + wr * 64 + fr, col0 = u.pn * BM + wc * 32 + 8 * fq;
        float gtv[2][4];
#pragma unroll
        for (int ai = 0; ai < 2; ++ai)
#pragma unroll
            for (int m = 0; m < 4; ++m) gtv[ai][m] = gate[row0 + ai * HALF + m * 16];
#pragma unroll
        for (int ai = 0; ai < 2; ++ai)
#pragma unroll
            for (int m = 0; m < 4; ++m) { const int row = row0 + ai * HALF + m * 16; const float gt = gtv[ai][m]; bf16_t* rowp = Y + (size_t)row * DM + col0;
#pragma unroll
                for (int bj = 0; bj < 2; ++bj) { const f32x4 v0 = acc[ai][bj][m][0] * gt, v1 = acc[ai][bj][m][1] * gt;
                    u32x4 w; w.x = cvtpk(v0[0], v0[1]); w.y = cvtpk(v0[2], v0[3]); w.z = cvtpk(v1[0], v1[1]); w.w = cvtpk(v1[2], v1[3]);
                    st16(rowp + bj * HALF, w); } }
    }
};

template <class Epi, class Sched, bool GATHER, int BAUX = 0>
__device__ __forceinline__ void gemm_phase(PG8_LAS unsigned char* lds, const Gemm g, const Sched& S, const Epi& E, const PG8_LAS int* rmap) {
    int tid_ = threadIdx.x; asm volatile("" : "+v"(tid_));
    const int tid = tid_, wid = __builtin_amdgcn_readfirstlane(tid >> 6), lane = tid & 63, wr = wid >> 2, wc = wid & 3, fr = lane & 15, fq = lane >> 4;
    const int K = g.K, nt = K / BK;
    const size_t kstep = (size_t)(BK * 2);
    const size_t hstep = (size_t)HALF * K * 2;
    const size_t tstep = 2 * hstep;
    int RA[2], CA[2]; unsigned voffB[2], offA[2][2], offN[2][2];
#pragma unroll
    for (int i = 0; i < 2; ++i) { int R, C; stage_rc(tid * 16 + i * 8192, R, C); const int Rb = (R & ~31) + perm32(R & 31);
        RA[i] = R; CA[i] = C; voffB[i] = (unsigned)(Rb * K + C) * 2u;
        offA[0][i] = (unsigned)(R * K + C) * 2u; offA[1][i] = offA[0][i] + (unsigned)hstep; offN[0][i] = offA[0][i]; offN[1][i] = offA[1][i]; }
    const unsigned ldsw = (unsigned)wid * 1024u;
    const int aoff = lds_byte(wr * 64 + fr, fq * 8), boff = lds_byte(wc * 32 + fr, fq * 8);
#define PG8_SA(b, h) (((b) * 2 + (h)) * HTB)
#define PG8_SB(b, h) ((4 + (b) * 2 + (h)) * HTB)
#define PG8_STAGE(bufoff, gbase, voff) do { _Pragma("unroll") for (int _i = 0; _i < 2; ++_i) \
        __builtin_amdgcn_global_load_lds((const unsigned*)((const char*)(gbase) + (voff)[_i]), (PG8_LAS unsigned*)(lds + (bufoff) + ldsw + _i * 8192), 16, 0, 0); } while (0)
#define PG8_STAGEB(bufoff, gbase, voff) do { _Pragma("unroll") for (int _i = 0; _i < 2; ++_i) \
        __builtin_amdgcn_global_load_lds((const unsigned*)((const char*)(gbase) + (voff)[_i]), (PG8_LAS unsigned*)(lds + (bufoff) + ldsw + _i * 8192), 16, 0, BAUX); } while (0)
#define PG8_LDA(dst, b, h) do { _Pragma("unroll") for (int m = 0; m < 4; ++m) _Pragma("unroll") for (int k = 0; k < 2; ++k) dst[m][k] = *(const PG8_LAS bf16x8*)(lds + PG8_SA(b, h) + aoff + m * 2048 + k * 1024); } while (0)
#define PG8_LDB(dst, b, h) do { _Pragma("unroll") for (int n = 0; n < 2; ++n) _Pragma("unroll") for (int k = 0; k < 2; ++k) dst[n][k] = *(const PG8_LAS bf16x8*)(lds + PG8_SB(b, h) + boff + n * 2048 + k * 1024); } while (0)
#define PG8_MMA(ai, bj, At, Bt) do { __builtin_amdgcn_s_setprio(1); _Pragma("unroll") for (int m = 0; m < 4; ++m) _Pragma("unroll") for (int n = 0; n < 2; ++n) _Pragma("unroll") for (int k = 0; k < 2; ++k) \
        acc[ai][bj][m][n] = __builtin_amdgcn_mfma_f32_16x16x32_bf16(Bt[n][k], At[m][k], acc[ai][bj][m][n], 0, 0, 0); __builtin_amdgcn_s_setprio(0); } while (0)
#define PG8_WAIT_V(n) asm volatile("s_waitcnt vmcnt(" #n ")" ::: "memory")
#define PG8_WAIT_L(n) asm volatile("s_waitcnt lgkmcnt(" #n ")" ::: "memory")
#define PG8_BAR __builtin_amdgcn_s_barrier()
#define PG8_SCHED __builtin_amdgcn_sched_barrier(0)
    Unit cur, nxt; int ui = 0;
    if (!S.next(0, cur)) return;
    f32x4 acc[2][2][4][2];
    if constexpr (Epi::INIT) E.init(acc, cur, wr, wc, fr, fq);
    else {
#pragma unroll
    for (int a = 0; a < 2; ++a)
#pragma unroll
        for (int b = 0; b < 2; ++b)
#pragma unroll
            for (int m = 0; m < 4; ++m)
#pragma unroll
                for (int n = 0; n < 2; ++n) acc[a][b][m][n] = (f32x4){0.f, 0.f, 0.f, 0.f};
    }
    bf16x8 At[4][2], B0[2][2], B1[2][2];
    if constexpr (GATHER) {
#pragma unroll
        for (int h = 0; h < 2; ++h)
#pragma unroll
            for (int i = 0; i < 2; ++i) { offA[h][i] = (unsigned)(rmap[h * HALF + RA[i]] * K + CA[i]) * 2u; offN[h][i] = offA[h][i]; }
    }
    const char* cA = (const char*)g.A + (GATHER ? (size_t)0 : (size_t)cur.pm * tstep); const char* cB = (const char*)g.Bt + (size_t)cur.pb * tstep;
    PG8_STAGEB(PG8_SB(0, 0), cB, voffB); PG8_STAGEB(PG8_SB(0, 1), cB + hstep, voffB); PG8_STAGE(PG8_SA(0, 0), cA, offA[0]); PG8_STAGE(PG8_SA(0, 1), cA, offA[1]);
    if (wr == 1) PG8_BAR;
    PG8_WAIT_V(2); PG8_BAR;
    PG8_STAGEB(PG8_SB(1, 0), cB + kstep, voffB); PG8_STAGE(PG8_SA(1, 0), cA + kstep, offA[0]); PG8_STAGEB(PG8_SB(1, 1), cB + hstep + kstep, voffB);
    PG8_WAIT_V(6); PG8_BAR;
    for (;;) {
        const bool has_next = S.next(ui + 1, nxt);
        const char* nA = (has_next && !GATHER) ? (const char*)g.A + (size_t)nxt.pm * tstep : cA; const char* nB = has_next ? (const char*)g.Bt + (size_t)nxt.pb * tstep : cB;
        if constexpr (GATHER) {
            if (has_next) {
#pragma unroll
                for (int h = 0; h < 2; ++h)
#pragma unroll
                    for (int i = 0; i < 2; ++i) offN[h][i] = (unsigned)(rmap[(ui + 1) * BM + h * HALF + RA[i]] * K + CA[i]) * 2u;
            }
        }
        for (int t = 0; t < nt; t += 2) {
            const bool last = (t == nt - 2);
            const char* a1 = cA + (size_t)(t + 1) * kstep;
            const char* a2 = last ? nA : cA + (size_t)(t + 2) * kstep; const char* b2 = last ? nB : cB + (size_t)(t + 2) * kstep;
            const char* a3 = a2 + kstep; const char* b3 = b2 + kstep;
            unsigned o2[2][2];
#pragma unroll
            for (int h = 0; h < 2; ++h)
#pragma unroll
                for (int i = 0; i < 2; ++i) o2[h][i] = (GATHER && last) ? offN[h][i] : offA[h][i];
            PG8_LDB(B0, 0, 0); PG8_LDB(B1, 0, 1); PG8_SCHED; PG8_LDA(At, 0, 0); PG8_STAGE(PG8_SA(1, 1), a1, offA[1]);
            PG8_WAIT_V(8); PG8_WAIT_L(0); PG8_BAR; PG8_MMA(0, 0, At, B0); PG8_MMA(0, 1, At, B1); PG8_BAR; PG8_SCHED;
            PG8_LDA(At, 0, 1); PG8_STAGEB(PG8_SB(0, 0), b2, voffB); PG8_STAGEB(PG8_SB(0, 1), b2 + hstep, voffB); PG8_STAGE(PG8_SA(0, 0), a2, o2[0]);
            PG8_WAIT_V(8); PG8_WAIT_L(0); PG8_BAR; PG8_MMA(1, 0, At, B0); PG8_MMA(1, 1, At, B1); PG8_BAR; PG8_SCHED;
            PG8_LDB(B0, 1, 0); PG8_LDB(B1, 1, 1); PG8_SCHED; PG8_LDA(At, 1, 0); PG8_STAGE(PG8_SA(0, 1), a2, o2[1]);
            PG8_WAIT_V(8); PG8_WAIT_L(0); PG8_BAR; PG8_MMA(0, 0, At, B0); PG8_MMA(0, 1, At, B1); PG8_BAR; PG8_SCHED;
            PG8_LDA(At, 1, 1); PG8_STAGEB(PG8_SB(1, 0), b3, voffB); PG8_STAGEB(PG8_SB(1, 1), b3 + hstep, voffB); PG8_STAGE(PG8_SA(1, 0), a3, o2[0]);
            PG8_WAIT_V(8); PG8_WAIT_L(0); PG8_BAR; PG8_MMA(1, 0, At, B0); PG8_MMA(1, 1, At, B1); PG8_BAR; PG8_SCHED;
        }
        if (wr == 0) PG8_BAR;
        E(acc, cur, wr, wc, fr, fq, ui);
        if (!has_next) break;
#pragma unroll
        for (int a = 0; a < 2; ++a)
#pragma unroll
            for (int b = 0; b < 2; ++b)
#pragma unroll
                for (int m = 0; m < 4; ++m)
#pragma unroll
                    for (int n = 0; n < 2; ++n) acc[a][b][m][n] = (f32x4){0.f, 0.f, 0.f, 0.f};
        cur = nxt; cA = nA; cB = nB; ++ui;
        if constexpr (GATHER) {
#pragma unroll
            for (int h = 0; h < 2; ++h)
#pragma unroll
                for (int i = 0; i < 2; ++i) offA[h][i] = offN[h][i];
        }
        if (wr == 1) PG8_BAR;
    }
    PG8_WAIT_V(0);
    PG8_BAR;
#undef PG8_SA
#undef PG8_SB
#undef PG8_STAGE
#undef PG8_STAGEB
#undef PG8_LDA
#undef PG8_LDB
#undef PG8_MMA
#undef PG8_WAIT_V
#undef PG8_WAIT_L
#undef PG8_BAR
#undef PG8_SCHED
}
}
#define XB_TMO      128
#define XB_XCNT(j)  (256  + 64 * (j))
#define XB_XSUB(j)  (1280 + 64 * (j))
#define XB_XGEN(j)  (2304 + 64 * (j))
#define XB_TOP      3328
#define XB_TOPGEN   3392
#define XCD_BAR_WORDS 3456
#define XB_SPIN_CAP (1u << 18)
#ifndef EARLY_WB
#define EARLY_WB 0
#endif
#ifndef INV_L1_ONLY
#define INV_L1_ONLY 1
#endif

__device__ __forceinline__ unsigned xb_ld(unsigned* p)              { return __hip_atomic_load(p, __ATOMIC_RELAXED, __HIP_MEMORY_SCOPE_AGENT); }
__device__ __forceinline__ unsigned xb_add(unsigned* p, unsigned v) { return __hip_atomic_fetch_add(p, v, __ATOMIC_RELAXED, __HIP_MEMORY_SCOPE_AGENT); }
__device__ __forceinline__ unsigned xb_xcc_id() { return (unsigned)__builtin_amdgcn_s_getreg((3 << 11) | 20) & 0xFu; }
#define XB_SPIN(cond, bar) do { unsigned _sp = 0; while (cond) { __builtin_amdgcn_s_sleep(1); \
    if ((++_sp & 255u) == 0u) { if (xb_ld(&(bar)[XB_TMO])) break; if (_sp > XB_SPIN_CAP) { atomicAdd(&(bar)[XB_TMO], 1u); break; } } } } while (0)

struct XcdBarrier {
    unsigned* bar; unsigned x;
    volatile LAS unsigned* st;
};

__device__ __forceinline__ XcdBarrier xcd_barrier_post(unsigned* bar, volatile LAS unsigned* st) {
    XcdBarrier b; b.bar = bar; b.x = xb_xcc_id(); b.st = st;
    if (threadIdx.x == 0) (void)xb_add(&bar[XB_XCNT(b.x)], 1u);
    return b;
}
__device__ __forceinline__ void xcd_barrier_complete(unsigned* bar, unsigned x, unsigned& nloc, unsigned& nx) {
    const unsigned G = gridDim.x * gridDim.y * gridDim.z;
    unsigned sum, cnt, mine, sp = 0u;
    for (;;) {
        sum = 0u; cnt = 0u; mine = 0u;
#pragma unroll
        for (unsigned j = 0; j < 16; ++j) { const unsigned c = xb_ld(&bar[XB_XCNT(j)]); sum += c; cnt += (c > 0u) ? 1u : 0u; mine = (j == x) ? c : mine; }
        if (sum == G) break;
        __builtin_amdgcn_s_sleep(1);
        if ((++sp & 255u) == 0u) { if (xb_ld(&bar[XB_TMO])) break; if (sp > XB_SPIN_CAP) { atomicAdd(&bar[XB_TMO], 1u); break; } }
    }
    nloc = mine > 0u ? mine : 1u; nx = cnt > 0u ? cnt : 1u;
}

__device__ __forceinline__ void xcd_barrier_census_wave(const XcdBarrier& b, int lane) {
    const unsigned G = gridDim.x * gridDim.y * gridDim.z; unsigned* bar = b.bar;
    unsigned c, sum, sp = 0u;
    for (;;) {
        c = lane < 16 ? xb_ld(&bar[XB_XCNT(lane & 15)]) : 0u;
        sum = c;
#pragma unroll
        for (int o = 1; o < 16; o <<= 1) sum += (unsigned)__builtin_amdgcn_ds_bpermute((lane ^ o) << 2, (int)sum);
        sum = (unsigned)__builtin_amdgcn_readfirstlane((int)sum);
        if (sum == G) break;
        __builtin_amdgcn_s_sleep(1);
        if ((++sp & 255u) == 0u) { if (xb_ld(&bar[XB_TMO])) break; if (sp > XB_SPIN_CAP) { if (lane == 0) atomicAdd(&bar[XB_TMO], 1u); break; } }
    }
    const unsigned cnt = (unsigned)__builtin_popcountll(__ballot(c > 0u));
    const unsigned mine = (unsigned)__builtin_amdgcn_readlane((int)c, (int)(b.x & 15u));
    if (lane == 0) { b.st[0] = mine > 0u ? mine : 1u; b.st[1] = cnt > 0u ? cnt : 1u; }
}

__device__ __forceinline__ void xcd_barrier(const XcdBarrier& b) {
    asm volatile("s_waitcnt vmcnt(0)" ::: "memory");
    __syncthreads();
    if (threadIdx.x == 0) {
        unsigned* bar = b.bar;
        __builtin_amdgcn_s_waitcnt(0);
        unsigned nloc = b.st[0], nx = b.st[1];
        if (nloc == 0u) { xcd_barrier_complete(bar, b.x, nloc, nx); b.st[0] = nloc; b.st[1] = nx; }
        const unsigned old = xb_add(&bar[XB_XSUB(b.x)], 1u);
        const unsigned gen = old / nloc;
        if (old + 1u == (gen + 1u) * nloc) {
            __builtin_amdgcn_fence(__ATOMIC_RELEASE, "agent");
            asm volatile("s_waitcnt vmcnt(0)" ::: "memory");
            const unsigned og = xb_add(&bar[XB_TOP], 1u);
            const unsigned tg = og / nx;
            if (og + 1u == (tg + 1u) * nx) xb_add(&bar[XB_TOPGEN], 1u);
            else XB_SPIN(xb_ld(&bar[XB_TOPGEN]) == tg, bar);
            __builtin_amdgcn_fence(__ATOMIC_ACQUIRE, "agent");
#if INV_L1_ONLY
            asm volatile("s_waitcnt vmcnt(0)" ::: "memory");
#endif
            xb_add(&bar[XB_XGEN(b.x)], 1u);
            asm volatile("s_waitcnt vmcnt(0)" ::: "memory");
        } else {
#if EARLY_WB
            asm volatile("buffer_wbl2 sc1" ::: "memory");
#endif
            XB_SPIN(xb_ld(&bar[XB_XGEN(b.x)]) == gen, bar);
#if INV_L1_ONLY
            asm volatile("s_waitcnt vmcnt(0)\n\tbuffer_inv sc0" ::: "memory");
#else
            __builtin_amdgcn_fence(__ATOMIC_ACQUIRE, "agent");
#endif
            asm volatile("s_waitcnt vmcnt(0)" ::: "memory");
        }
    }
    __syncthreads();
}

__device__ __forceinline__ void wg_arrive(unsigned* ctr) {
    asm volatile("s_waitcnt vmcnt(0)" ::: "memory");
    __syncthreads();
    if (threadIdx.x == 0) {
        __builtin_amdgcn_fence(__ATOMIC_RELEASE, "agent");
        asm volatile("s_waitcnt vmcnt(0)" ::: "memory");
        (void)xb_add(ctr, 1u);
    }
}
__device__ __forceinline__ void wg_wait(unsigned* ctr, unsigned target, unsigned* tmo) {
    if (threadIdx.x == 0) {
        unsigned sp = 0u;
        while (xb_ld(ctr) < target) { __builtin_amdgcn_s_sleep(1); if ((++sp & 255u) == 0u) { if (xb_ld(tmo)) break; if (sp > XB_SPIN_CAP) { atomicAdd(tmo, 1u); break; } } }
        __builtin_amdgcn_fence(__ATOMIC_ACQUIRE, "agent");
        asm volatile("s_waitcnt vmcnt(0)" ::: "memory");
    }
    __syncthreads();
}
struct Ctx { LAS unsigned char* lds; int tid, lane, wave, G, bid, gw, NGW; };
#define LDS_WAIT() asm volatile("s_waitcnt lgkmcnt(0)" ::: "memory")

#ifndef LAZY_CONVERT
#define LAZY_CONVERT 1
#endif
#ifndef JIT_CONVERT
#define JIT_CONVERT 1
#endif
struct TItem { const float* src; bf16_t* dst; const float* ksc; int ldw, nv, ldk; f32x4 k0, k1; };
__device__ __forceinline__ TItem prologue_item(const Args& a, int it) {
    constexpr int I_IN = 32 * 160, I_OUT = 32 * 64, I_GU = 16 * 32 * 64, I_DN = 16 * 16 * 64, I_L = I_IN + I_OUT + I_GU + I_DN;
    bf16_t* WIN = (bf16_t*)(a.ws + WS_WIN); bf16_t* WOUT = (bf16_t*)(a.ws + WS_WOUT); bf16_t* WGU = (bf16_t*)(a.ws + WS_WGU); bf16_t* WDN = (bf16_t*)(a.ws + WS_WDN);
    const int l = it / I_L; int r = it % I_L; TItem t; t.ksc = nullptr;
    if (r < I_IN) { const int kb = r / 160, nb = r % 160, k0 = 64 * kb, n0 = 32 * nb; int s0, nv;
        if (n0 < 3840) { s0 = n0; nv = 32; } else if (n0 < 4864) { s0 = n0 + 16; nv = 32; } else if (n0 == 4864) { s0 = 3840; nv = 16; } else { s0 = 0; nv = 0; }
        t.ksc = a.in[1] + (size_t)l * DM + k0;
        t.src = a.in[2] + (size_t)l * DM * INW + (size_t)k0 * INW + s0; t.ldw = INW; t.nv = nv; t.dst = WIN + (size_t)l * NU * DM + (size_t)n0 * DM + k0; t.ldk = DM; return t; }
    r -= I_IN;
    if (r < I_OUT) { const int kb = r / 64, nb = r % 64, k0 = 64 * kb, n0 = 32 * nb;
        t.src = a.in[19] + (size_t)l * DM * DM + (size_t)k0 * DM + n0; t.ldw = DM; t.nv = 32; t.dst = WOUT + (size_t)l * DM * DM + (size_t)n0 * DM + k0; t.ldk = DM; return t; }
    r -= I_OUT;
    if (r < I_GU) { const int e = r / 2048, rr = r % 2048, kb = rr / 64, nb = rr % 64, k0 = 64 * kb, n0 = 32 * nb, pn = n0 >> 8, rt = n0 & 255;
        const float* W = (rt < 128 ? a.in[22] : a.in[23]) + (size_t)(l * NEXP + e) * DM * FF; const int s0 = 128 * pn + (rt & 127);
        t.ksc = a.in[20] + (size_t)l * DM + k0;
        t.src = W + (size_t)k0 * FF + s0; t.ldw = FF; t.nv = 32; t.dst = WGU + ((size_t)(l * NEXP + e) * 2048 + n0) * DM + k0; t.ldk = DM; return t; }
    r -= I_GU;
    { const int e = r / 1024, rr = r % 1024, kb = rr / 64, nb = rr % 64, k0 = 64 * kb, n0 = 32 * nb;
        t.src = a.in[24] + (size_t)(l * NEXP + e) * FF * DM + (size_t)k0 * DM + n0; t.ldw = DM; t.nv = 32; t.dst = WDN + ((size_t)(l * NEXP + e) * 2048 + n0) * FF + k0; t.ldk = FF; return t; }
}
__device__ __forceinline__ void titem_load(TItem& t, f32x4 (&v)[8], int lane) {
    const int q = lane & 7, rr = lane >> 3;
    t.k0 = (f32x4){1.f, 1.f, 1.f, 1.f}; t.k1 = t.k0;
    if (t.ksc) { t.k0 = *(const f32x4*)(t.ksc + 8 * (lane & 7)); t.k1 = *(const f32x4*)(t.ksc + 8 * (lane & 7) + 4); }
#pragma unroll
    for (int i = 0; i < 8; ++i) { v[i] = (f32x4){0.f, 0.f, 0.f, 0.f}; if (4 * q < t.nv) v[i] = __builtin_nontemporal_load((const f32x4*)(t.src + (size_t)(8 * i + rr) * t.ldw + 4 * q)); }
}
__device__ __forceinline__ void titem_store(const TItem& t, const f32x4 (&v)[8], LAS float* scr, int lane) {
    const int q = lane & 7, rr = lane >> 3;
#pragma unroll
    for (int i = 0; i < 8; ++i) { LAS float* s = scr + (8 * i + rr) * 33 + 4 * q; s[0] = v[i][0]; s[1] = v[i][1]; s[2] = v[i][2]; s[3] = v[i][3]; }
    LDS_WAIT();
    const int c = lane & 7;
    const f32x4 k0 = t.k0, k1 = t.k1;
#pragma unroll
    for (int j = 0; j < 4; ++j) { const int n = (lane >> 3) + 8 * j; const LAS float* s = scr + (8 * c) * 33 + n;
        u32x4 o; o.x = cvtpk(s[0 * 33] * k0[0], s[1 * 33] * k0[1]); o.y = cvtpk(s[2 * 33] * k0[2], s[3 * 33] * k0[3]); o.z = cvtpk(s[4 * 33] * k1[0], s[5 * 33] * k1[1]); o.w = cvtpk(s[6 * 33] * k1[2], s[7 * 33] * k1[3]);
        __builtin_nontemporal_store(o, (u32x4*)(t.dst + (size_t)n * t.ldk + 8 * c)); }
    LDS_WAIT();
}
__device__ __forceinline__ void convert_items(const Args& a, const Ctx& X, int first, int count) {
    LAS float* scr = (LAS float*)(X.lds + X.wave * 16384);
    const int n_it = (count - X.gw + X.NGW - 1) / X.NGW;
    if (n_it <= 0) return;
    TItem t0, t1, t2, t3; f32x4 v0[8], v1[8], v2[8], v3[8];
    t0 = prologue_item(a, first + X.gw); titem_load(t0, v0, X.lane);
    t1 = t0; t2 = t0; t3 = t0;
    if (n_it > 1) { t1 = prologue_item(a, first + X.gw + X.NGW); titem_load(t1, v1, X.lane); }
    if (n_it > 2) { t2 = prologue_item(a, first + X.gw + 2 * X.NGW); titem_load(t2, v2, X.lane); }
#pragma unroll 1
    for (int i = 0; i < n_it; i += 4) {
        if (i + 3 < n_it) { t3 = prologue_item(a, first + X.gw + (i + 3) * X.NGW); titem_load(t3, v3, X.lane); }
        titem_store(t0, v0, scr, X.lane);
        if (i + 1 >= n_it) break;
        if (i + 4 < n_it) { t0 = prologue_item(a, first + X.gw + (i + 4) * X.NGW); titem_load(t0, v0, X.lane); }
        titem_store(t1, v1, scr, X.lane);
        if (i + 2 >= n_it) break;
        if (i + 5 < n_it) { t1 = prologue_item(a, first + X.gw + (i + 5) * X.NGW); titem_load(t1, v1, X.lane); }
        titem_store(t2, v2, scr, X.lane);
        if (i + 3 >= n_it) break;
        if (i + 6 < n_it) { t2 = prologue_item(a, first + X.gw + (i + 6) * X.NGW); titem_load(t2, v2, X.lane); }
        titem_store(t3, v3, scr, X.lane);
    }
}
constexpr int CV_IN = 32 * 160, CV_IL = 32 * 160 + 32 * 64 + 16 * 32 * 64 + 16 * 16 * 64;
__device__ __forceinline__ void convert_layer_weights(const Args& a, const Ctx& X, int l) { convert_items(a, X, l * CV_IL, CV_IL); }
#ifndef TOPK_CONV
#define TOPK_CONV 1
#endif
constexpr int CV_TK = TOPK_CONV ? 2 * 8 * (256 - NB * NEXP) : 0;
__device__ __forceinline__ bool topk_conv_on(const Ctx& X) { return TOPK_CONV && X.G == 256; }
__device__ __forceinline__ void convert_jit(const Args& a, const Ctx& X, int l) { const int skip = (l > 0 && topk_conv_on(X)) ? CV_TK : 0;
    convert_items(a, X, l * CV_IL + CV_IN + skip, ((l + 1 < DEPTH) ? CV_IL : CV_IL - CV_IN) - skip); }
__device__ __forceinline__ void convert_in_topk(const Args& a, const Ctx& X, int l) {
    if (!topk_conv_on(X) || X.bid < NB * NEXP) return;
    Ctx Xc = X; Xc.bid -= NB * NEXP; Xc.G -= NB * NEXP; Xc.gw = Xc.bid * 8 + Xc.wave; Xc.NGW = Xc.G * 8;
    convert_items(a, Xc, (l + 1) * CV_IL + CV_IN, CV_TK); }
__device__ __forceinline__ void phase_prologue(const Args& a, const Ctx& X) {
#if LAZY_CONVERT && JIT_CONVERT
    convert_items(a, X, 0, CV_IN);
#elif LAZY_CONVERT
    convert_layer_weights(a, X, 0);
#else
    for (int l = 0; l < DEPTH; ++l) convert_layer_weights(a, X, l);
#endif
    { unsigned short* RTW = (unsigned short*)(a.ws + WS_RTW);
      for (int i = X.bid * 512 + X.tid; i < DEPTH * DM * NEXP; i += X.G * 512) { const int l = i / (DM * NEXP), r = i % (DM * NEXP), k = r >> 4, e = r & 15;
          const float w = a.in[21][i] * a.in[20][l * DM + k];
          const unsigned hi = cvtpk(w, 0.f) & 0xffffu; const unsigned lo = cvtpk(w - __uint_as_float(hi << 16), 0.f) & 0xffffu;
          RTW[((size_t)(l * 2 + 0) * NEXP + e) * DM + k] = (unsigned short)hi; RTW[((size_t)(l * 2 + 1) * NEXP + e) * DM + k] = (unsigned short)lo; } }
    float* rope = (float*)(a.ws + WS_ROPE);
    for (int i = X.bid * 512 + X.tid; i < SEQ * 8; i += X.G * 512) { const int pos = i >> 3, k = i & 7;
        const double ivf = k == 0 ? 0.15915494309189535 : k == 1 ? 0.03086376340470123 : k == 2 ? 0.0059851857127137054 : k == 3 ? 0.001160663641240061 : k == 4 ? 0.00022507907903927653 : k == 5 ? 4.3647952792802891e-05 : k == 6 ? 8.4643308082414014e-06 : 1.6414262627950345e-06;
        const double rev = (double)pos * ivf; const float fr = (float)(rev - __builtin_floor(rev));
        rope[pos * 16 + k] = __builtin_amdgcn_cosf(fr); rope[pos * 16 + 8 + k] = __builtin_amdgcn_sinf(fr); }
}

__device__ __forceinline__ void phase_pre(const Args& a, const Ctx& X, int l, bool dummy = false) {
    bf16_t* XR = (bf16_t*)(a.ws + WS_XR);
    const int* sel = (const int*)(a.ws + WS_SEL); const bf16_t* Y = (const bf16_t*)(a.ws + WS_Y);
    bf16_t* XW = dummy ? (bf16_t*)(a.ws + WS_U) : XR; float* RS1 = (float*)(a.ws + (dummy ? WS_MIX : WS_RSTD1));
    for (int m = X.gw; m < T; m += X.NGW) {
        float v[4][8];
        int myslot = -1;
        if (l > 0 && X.lane < 16) myslot = sel[m * 16 + X.lane];
        if (l == 0) {
#pragma unroll
            for (int j = 0; j < 4; ++j) { const f32x4 a0 = *(const f32x4*)(a.in[0] + (size_t)m * DM + 8 * X.lane + 512 * j), a1 = *(const f32x4*)(a.in[0] + (size_t)m * DM + 8 * X.lane + 512 * j + 4);
                v[j][0] = a0[0]; v[j][1] = a0[1]; v[j][2] = a0[2]; v[j][3] = a0[3]; v[j][4] = a1[0]; v[j][5] = a1[1]; v[j][6] = a1[2]; v[j][7] = a1[3]; }
        } else {
            u32x4 xw[4];
#pragma unroll
            for (int j = 0; j < 4; ++j) xw[j] = *(const u32x4*)(XR + (size_t)m * DM + 8 * X.lane + 512 * j);
#pragma unroll
            for (int j = 0; j < 4; ++j) unpack8(xw[j], v[j]);
            unsigned long long mask = __ballot(myslot >= 0);
            while (mask) {
                int s4[4];
#pragma unroll
                for (int q = 0; q < 4; ++q) { s4[q] = -1; if (mask) { const int e = __builtin_ctzll(mask); mask &= mask - 1; s4[q] = shl_i(myslot, e); } }
                u32x4 w[4][4];
#pragma unroll
                for (int q = 0; q < 4; ++q) { const bf16_t* yr = Y + (size_t)(s4[q] < 0 ? 0 : s4[q]) * DM + 8 * X.lane;
#pragma unroll
                    for (int j = 0; j < 4; ++j) { w[q][j] = (u32x4){0u, 0u, 0u, 0u}; if (s4[q] >= 0) w[q][j] = *(const u32x4*)(yr + 512 * j); } }
#pragma unroll
                for (int q = 0; q < 4; ++q)
#pragma unroll
                    for (int j = 0; j < 4; ++j) { float f[8]; unpack8(w[q][j], f);
#pragma unroll
                        for (int e = 0; e < 8; ++e) v[j][e] += f[e]; }
            }
        }
        if (l < DEPTH) {
            float ss = 0.f;
#pragma unroll
            for (int j = 0; j < 4; ++j) { u32x4 o; o.x = cvtpk(v[j][0], v[j][1]); o.y = cvtpk(v[j][2], v[j][3]); o.z = cvtpk(v[j][4], v[j][5]); o.w = cvtpk(v[j][6], v[j][7]);
                *(u32x4*)(XW + (size_t)m * DM + 8 * X.lane + 512 * j) = o;
#pragma unroll
                for (int e = 0; e < 8; ++e) ss += v[j][e] * v[j][e]; }
            const float rstd = rsqrtf(wsum(ss) * (1.f / DM) + EPS);
            if (X.lane == 0) RS1[m] = rstd;
        } else {
#pragma unroll
            for (int j = 0; j < 4; ++j) { float* o = a.out + (size_t)m * DM + 8 * X.lane + 512 * j; __builtin_nontemporal_store((f32x4){v[j][0], v[j][1], v[j][2], v[j][3]}, (f32x4*)o); __builtin_nontemporal_store((f32x4){v[j][4], v[j][5], v[j][6], v[j][7]}, (f32x4*)(o + 4)); }
        }
    }
}

__device__ __forceinline__ void phase_router(const Args& a, const Ctx& X, int l) {
    LAS float* WR = (LAS float*)X.lds;
    const float* wr = a.in[21] + (size_t)l * DM * NEXP; const float* nw = a.in[20] + (size_t)l * DM;
    for (int i = X.tid; i < DM * NEXP; i += 512) { const int k = i >> 4, e = i & 15; WR[e * DM + (k >> 9) * 512 + ((k >> 2) & 1) * 256 + ((k & 511) >> 3) * 4 + (k & 3)] = wr[i] * nw[k]; }
    __syncthreads();
    float* AFF = (float*)(a.ws + WS_AFF); const bf16_t* XR = (const bf16_t*)(a.ws + WS_XR); float* RSTD = (float*)(a.ws + WS_RSTD);
    for (int m0 = 4 * X.gw; m0 < T; m0 += 4 * X.NGW) {
        float v[4][4][8];
        {
            u32x4 xw[4][4];
#pragma unroll
            for (int r = 0; r < 4; ++r)
#pragma unroll
                for (int j = 0; j < 4; ++j) xw[r][j] = *(const u32x4*)(XR + (size_t)(m0 + r) * DM + 8 * X.lane + 512 * j);
#pragma unroll
            for (int r = 0; r < 4; ++r)
#pragma unroll
                for (int j = 0; j < 4; ++j) unpack8(xw[r][j], v[r][j]);
        }
        float rstd[4];
#pragma unroll
        for (int r = 0; r < 4; ++r) { float ss = 0.f;
#pragma unroll
            for (int j = 0; j < 4; ++j)
#pragma unroll
                for (int e = 0; e < 8; ++e) ss += v[r][j][e] * v[r][j][e];
            rstd[r] = rsqrtf(wsum(ss) * (1.f / DM) + EPS);
            if (X.lane == 0) RSTD[m0 + r] = rstd[r]; }
        float mine[4] = {-INFINITY, -INFINITY, -INFINITY, -INFINITY};
#pragma unroll 1
        for (int e = 0; e < 16; ++e) { float acc[4] = {0.f, 0.f, 0.f, 0.f};
#pragma unroll
            for (int j = 0; j < 4; ++j)
#pragma unroll
                for (int hf = 0; hf < 2; ++hf) { const f32x4 w = *(const LAS f32x4*)(WR + e * DM + j * 512 + hf * 256 + 4 * X.lane);
#pragma unroll
                    for (int r = 0; r < 4; ++r) acc[r] += (v[r][j][4 * hf] * w[0] + v[r][j][4 * hf + 1] * w[1]) + (v[r][j][4 * hf + 2] * w[2] + v[r][j][4 * hf + 3] * w[3]); }
#pragma unroll
            for (int r = 0; r < 4; ++r) { const float t = wsum(acc[r]) * rstd[r]; mine[r] = (X.lane == e) ? t : mine[r]; } }
#pragma unroll
        for (int r = 0; r < 4; ++r) { float mx = mine[r];
#pragma unroll
            for (int o = 1; o < 16; o <<= 1) mx = fmaxf(mx, shx(mx, o));
            float pr = (X.lane < 16) ? __expf(mine[r] - mx) : 0.f; float sum = pr;
#pragma unroll
            for (int o = 1; o < 16; o <<= 1) sum += shx(sum, o);
            const int m = m0 + r;
            if (X.lane < 16) AFF[(size_t)((m >> 13) * 16 + X.lane) * SEQ + (m & 8191)] = pr / sum; }
    }
    __syncthreads();
}

constexpr int RT_PITCH = DM * 2 + 16;
constexpr int RT_CMB = 32 * RT_PITCH, RT_RS = RT_CMB + 4 * 64 * 5 * 4;
static_assert(RT_RS + 4 * 16 * 4 <= LDSCTL_OFF, "router LDS map");
__device__ __forceinline__ void phase_router_mfma(const Args& a, const Ctx& X, int l) {
    const bf16_t* XR = (const bf16_t*)(a.ws + WS_XR); float* AFF = (float*)(a.ws + WS_AFF); float* RSTD = (float*)(a.ws + WS_RSTD);
    const int fr = X.lane & 15, fq = X.lane >> 4, tile = X.wave & 3, kh = X.wave >> 2;
    constexpr int NRB = T / 64;
    int rb = X.bid;
    bf16x8 af[32];
    if (rb < NRB) { const bf16_t* xp = XR + (size_t)(rb * 64 + tile * 16 + fr) * DM + kh * 1024 + fq * 8;
#pragma unroll
        for (int s = 0; s < 32; ++s) af[s] = *(const bf16x8*)(xp + s * 32); }
    { const char* RTW = (const char*)(a.ws + WS_RTW) + (size_t)l * 2 * NEXP * DM * 2;
#pragma unroll
      for (int h = 0; h < 2; ++h) { u32x4 tw[8];
#pragma unroll
          for (int i = 0; i < 8; ++i) tw[i] = *(const u32x4*)(RTW + (size_t)(X.tid + 512 * (8 * h + i)) * 16);
#pragma unroll
          for (int i = 0; i < 8; ++i) { const int c = X.tid + 512 * (8 * h + i); *(LAS u32x4*)(X.lds + (c >> 8) * RT_PITCH + (c & 255) * 16) = tw[i]; } } }
    __syncthreads();
    LAS float* cmb = (LAS float*)(X.lds + RT_CMB) + (tile * 64 + X.lane) * 5; LAS float* rs = (LAS float*)(X.lds + RT_RS) + tile * 16;
#pragma unroll 1
    for (; rb < NRB; rb += X.G) {
        const int m0 = rb * 64 + tile * 16;
        f32x4 acc = (f32x4){0.f, 0.f, 0.f, 0.f}; float ss = 0.f;
        const LAS unsigned char* tb = X.lds + fr * RT_PITCH + (kh * 1024 + fq * 8) * 2;
#pragma unroll
        for (int s = 0; s < 32; ++s) { const bf16x8 bh = *(const LAS bf16x8*)(tb + s * 64), bl = *(const LAS bf16x8*)(tb + 16 * RT_PITCH + s * 64);
            acc = __builtin_amdgcn_mfma_f32_16x16x32_bf16(af[s], bh, acc, 0, 0, 0); acc = __builtin_amdgcn_mfma_f32_16x16x32_bf16(af[s], bl, acc, 0, 0, 0);
            float t[8]; unpack8(__builtin_bit_cast(u32x4, af[s]), t);
#pragma unroll
            for (int j = 0; j < 8; ++j) ss += t[j] * t[j]; }
        ss += shx(ss, 16); ss += shx(ss, 32);
        if (kh == 1) { cmb[0] = acc[0]; cmb[1] = acc[1]; cmb[2] = acc[2]; cmb[3] = acc[3]; cmb[4] = ss; }
        __syncthreads();
        if (kh == 0) {
            acc[0] += cmb[0]; acc[1] += cmb[1]; acc[2] += cmb[2]; acc[3] += cmb[3]; ss += cmb[4];
            const float rstd = rsqrtf(ss * (1.f / DM) + EPS);
            if (fq == 0) { RSTD[m0 + fr] = rstd; rs[fr] = rstd; }
            LDS_WAIT();
            f32x4 pr;
#pragma unroll
            for (int r = 0; r < 4; ++r) { const float lg = acc[r] * rs[4 * fq + r];
                float mx = lg;
#pragma unroll
                for (int o = 1; o < 16; o <<= 1) mx = fmaxf(mx, shx(mx, o));
                const float p = __expf(lg - mx); float sum = p;
#pragma unroll
                for (int o = 1; o < 16; o <<= 1) sum += shx(sum, o);
                pr[r] = p / sum; }
            const int mq = m0 + 4 * fq;
            *(f32x4*)(AFF + (size_t)((mq >> 13) * 16 + fr) * SEQ + (mq & 8191)) = pr;
        }
        if (rb + X.G < NRB) { const bf16_t* xp = XR + (size_t)((rb + X.G) * 64 + tile * 16 + fr) * DM + kh * 1024 + fq * 8;
#pragma unroll
            for (int s = 0; s < 32; ++s) af[s] = *(const bf16x8*)(xp + s * 32); }
        __syncthreads();
    }
}

__device__ __forceinline__ void topk_run(const Args& a, const Ctx& X, int be, bool publish, LAS int* rl, int ntab, int slot_base) {
    LAS unsigned* keys = (LAS unsigned*)X.lds; LAS unsigned* hist = keys + 8192; LAS unsigned* suf = hist + 256; LAS unsigned* ctl = suf + 256; LAS unsigned* wtot = ctl + 16;
    const int b = be >> 4, e = be & 15;
    const unsigned* src = (const unsigned*)(a.ws + WS_AFF) + (size_t)be * SEQ;
    { unsigned kv[16];
#pragma unroll
      for (int j = 0; j < 16; ++j) kv[j] = src[X.tid + 512 * j];
#pragma unroll
      for (int j = 0; j < 16; ++j) keys[X.tid + 512 * j] = kv[j]; }
    __syncthreads();
    unsigned prefix = 0u, mask = 0u, need = CAP;
    for (int pass = 0; pass < 4; ++pass) {
        const int shift = 24 - 8 * pass;
        if (X.tid < 256) hist[X.tid] = 0u;
        __syncthreads();
        for (int i = X.tid; i < SEQ; i += 512) { const unsigned k = keys[i]; if ((k & mask) == prefix) __hip_atomic_fetch_add(&hist[(k >> shift) & 255u], 1u, __ATOMIC_RELAXED, __HIP_MEMORY_SCOPE_WORKGROUP); }
        __syncthreads();
        if (X.wave == 0) {
            const u32x4 hv = *(const LAS u32x4*)(hist + 4 * X.lane);
            const unsigned own = hv.x + hv.y + hv.z + hv.w;
            unsigned incl = own;
#pragma unroll
            for (int o = 1; o < 64; o <<= 1) { const unsigned t = (unsigned)shdn_i((int)incl, o); if (X.lane + o < 64) incl += t; }
            const unsigned above = incl - own;
            const unsigned s3 = above + hv.w, s2 = s3 + hv.z, s1 = s2 + hv.y, s0 = s1 + hv.x;
            if (s3 >= need && above < need) { ctl[0] = 4 * X.lane + 3; ctl[1] = need - above; }
            else if (s2 >= need && s3 < need) { ctl[0] = 4 * X.lane + 2; ctl[1] = need - s3; }
            else if (s1 >= need && s2 < need) { ctl[0] = 4 * X.lane + 1; ctl[1] = need - s2; }
            else if (s0 >= need && s1 < need) { ctl[0] = 4 * X.lane; ctl[1] = need - s1; }
        }
        __syncthreads();
        prefix |= ctl[0] << shift; mask |= 0xffu << shift; need = ctl[1];
        __syncthreads();
    }
    const unsigned tk = prefix;
    unsigned k[16];
#pragma unroll
    for (int j = 0; j < 4; ++j) { const u32x4 w = *(const LAS u32x4*)(keys + X.tid * 16 + 4 * j); k[4 * j] = w.x; k[4 * j + 1] = w.y; k[4 * j + 2] = w.z; k[4 * j + 3] = w.w; }
    unsigned cnt = 0u;
#pragma unroll
    for (int j = 0; j < 16; ++j) cnt += (k[j] > tk ? 1u : 0u) + (k[j] == tk ? 0x10000u : 0u);
    unsigned v = cnt;
#pragma unroll
    for (int o = 1; o < 64; o <<= 1) { const unsigned t = (unsigned)shup_i((int)v, o); if (X.lane >= o) v += t; }
    if (X.lane == 63) wtot[X.wave] = v;
    __syncthreads();
    unsigned base = 0u, total = 0u;
#pragma unroll
    for (int w = 0; w < 8; ++w) { const unsigned t = wtot[w]; total += t; if (w < X.wave) base += t; }
    unsigned ex = base + v - cnt; unsigned gtb = ex & 0xffffu, eqb = ex >> 16; const unsigned ngt = total & 0xffffu;
    int* SEL = (int*)(a.ws + WS_SEL); int* RMAP = (int*)(a.ws + WS_RMAP); float* GATE = (float*)(a.ws + WS_GATE);
#pragma unroll
    for (int j = 0; j < 16; ++j) { const int tok = b * SEQ + X.tid * 16 + j; int slot = -1;
        if (k[j] > tk) { slot = (int)gtb; ++gtb; } else if (k[j] == tk) { if (eqb < need) slot = (int)(ngt + eqb); ++eqb; }
        const int row = e * 2048 + b * 1024 + slot;
        if (publish) { SEL[tok * 16 + e] = slot >= 0 ? row : -1; if (slot >= 0) { RMAP[row] = tok; GATE[row] = __uint_as_float(k[j]); } }
        if (rl && slot >= slot_base && slot < slot_base + 256) { rl[slot - slot_base] = tok; if (ntab > 1) rl[256 + slot - slot_base] = tok; } }
    __syncthreads();
}
__device__ __forceinline__ void phase_topk(const Args& a, const Ctx& X) {
    if (X.bid >= NB * NEXP) return;
    topk_run(a, X, X.bid, true, nullptr, 0, 0);
}

__device__ __forceinline__ void phase_ssd_prep(const Args& a, const Ctx& X, int l) {
    const bf16_t* U = (const bf16_t*)(a.ws + WS_U); float* XB = (float*)(a.ws + WS_XBC);
    const float* cw = a.in[9] + (size_t)l * 5 * 1024; const float* cb = a.in[10] + (size_t)l * 1024;
    for (int it = X.bid * 512 + X.tid; it < T * 128; it += X.G * 512) {
        const int m = it >> 7, c = (it & 127) * 8, t = m & 8191;
        float acc[8]; { const f32x4 b0 = *(const f32x4*)(cb + c), b1 = *(const f32x4*)(cb + c + 4); acc[0] = b0[0]; acc[1] = b0[1]; acc[2] = b0[2]; acc[3] = b0[3]; acc[4] = b1[0]; acc[5] = b1[1]; acc[6] = b1[2]; acc[7] = b1[3]; }
#pragma unroll
        for (int k = 0; k < 5; ++k) { const int tt = t + k - 2;
            if (tt >= 0 && tt < SEQ) { const u32x4 w = *(const u32x4*)(U + (size_t)(m + k - 2) * NU + U_XBC + c); float f[8]; unpack8(w, f);
                const f32x4 w0 = *(const f32x4*)(cw + k * 1024 + c), w1 = *(const f32x4*)(cw + k * 1024 + c + 4);
                acc[0] += f[0] * w0[0]; acc[1] += f[1] * w0[1]; acc[2] += f[2] * w0[2]; acc[3] += f[3] * w0[3]; acc[4] += f[4] * w1[0]; acc[5] += f[5] * w1[1]; acc[6] += f[6] * w1[2]; acc[7] += f[7] * w1[3]; } }
        f32x4 o0, o1; o0[0] = siluf_(acc[0]); o0[1] = siluf_(acc[1]); o0[2] = siluf_(acc[2]); o0[3] = siluf_(acc[3]); o1[0] = siluf_(acc[4]); o1[1] = siluf_(acc[5]); o1[2] = siluf_(acc[6]); o1[3] = siluf_(acc[7]);
        *(f32x4*)(XB + (size_t)m * 1024 + c) = o0; *(f32x4*)(XB + (size_t)m * 1024 + c + 4) = o1;
    }
    const float* dtraw = (const float*)(a.ws + WS_DTRAW); float* DT = (float*)(a.ws + WS_DT); const float* dtb = a.in[11] + l * 16;
    for (int it = X.bid * 512 + X.tid; it < T * 16; it += X.G * 512) DT[it] = softplusf_(dtraw[it] + dtb[it & 15]);
}

__device__ __forceinline__ void na_slow_item(const Args& a, int l, int m, int h, LAS float* sc, int lane) {
    const bf16_t* U = (const bf16_t*)(a.ws + WS_U); bf16_t* MIX = (bf16_t*)(a.ws + WS_MIX);
    const int b = m >> 13, t = m & 8191, r = t >> 6, c = t & 63;
    const int r0 = min(max(r - 4, 0), 120), c0 = min(max(c - 8, 0), 48);
    const float* qw = a.in[3] + l * 64; const float* kw = a.in[4] + l * 64; const float* rpb = a.in[5] + (size_t)(l * 8 + h) * 15 * 31;
    const float qv = bf1(U[(size_t)m * NU + U_NAQ + h * 64 + lane]);
    const float qn = qv * rsqrtf(wsum(qv * qv) * (1.f / 64.f) + EPS) * qw[lane] * 0.125f * kw[lane];
    sc[lane] = qn;
    LDS_WAIT();
    float lg[2];
#pragma unroll
    for (int jj = 0; jj < 2; ++jj) { const int j = lane + 64 * jj, kr = r0 + (j >> 4), kc = c0 + (j & 15), kt = b * SEQ + kr * 64 + kc;
        const u32x4* kp = (const u32x4*)(U + (size_t)kt * NU + U_NAK + h * 64); float dot = 0.f, s2 = 0.f;
#pragma unroll
        for (int ch = 0; ch < 8; ++ch) { const u32x4 w = kp[ch]; float f[8]; unpack8(w, f);
#pragma unroll
            for (int e = 0; e < 8; ++e) { dot += sc[ch * 8 + e] * f[e]; s2 += f[e] * f[e]; } }
        lg[jj] = dot * rsqrtf(s2 * (1.f / 64.f) + EPS) + rpb[(kr - r + 7) * 31 + (kc - c + 15)]; }
    const float mx = wmax(fmaxf(lg[0], lg[1]));
    const float p0 = __expf(lg[0] - mx), p1 = __expf(lg[1] - mx); const float inv = 1.0f / wsum(p0 + p1);
    sc[64 + lane] = p0 * inv; sc[128 + lane] = p1 * inv;
    LDS_WAIT();
    float o = 0.f;
#pragma unroll 8
    for (int j = 0; j < 128; ++j) { const int kt = b * SEQ + (r0 + (j >> 4)) * 64 + c0 + (j & 15); o += sc[64 + j] * bf1(U[(size_t)kt * NU + U_NAV + h * 64 + lane]); }
    MIX[(size_t)m * DM + h * 64 + lane] = (bf16_t)(cvtpk(o, 0.f) & 0xffffu);
    LDS_WAIT();
}

__device__ __forceinline__ void swa_slow_item(const Args& a, int l, int m, int hq, LAS float* sc, int lane) {
    const bf16_t* U = (const bf16_t*)(a.ws + WS_U); bf16_t* MIX = (bf16_t*)(a.ws + WS_MIX); const float* rope = (const float*)(a.ws + WS_ROPE);
    const int b = m >> 13, t = m & 8191, kvh = hq >> 2;
    const float* qnw = a.in[6] + l * 64; const float* knw = a.in[7] + l * 64; const float sink = a.in[8][l * 8 + hq];
    const float qv = bf1(U[(size_t)m * NU + U_WAQ + hq * 64 + lane]);
    const float qn = qv * rsqrtf(wsum(qv * qv) * (1.f / 64.f) + EPS) * qnw[lane];
    const float partner = shx(qn, 8);
    const float cs = (lane < 16) ? rope[t * 16 + (lane & 7)] : 1.f, sn = (lane < 16) ? rope[t * 16 + 8 + (lane & 7)] : 0.f;
    const float qr = (lane < 8) ? qn * cs - partner * sn : (lane < 16 ? qn * cs + partner * sn : qn);
    sc[lane] = qr * 0.125f; sc[64 + lane] = knw[lane];
    LDS_WAIT();
    const int lo = max(0, t - 128), hi = min(SEQ - 1, t + 128), n = hi - lo + 1;
    float lg[5]; float mx = sink;
#pragma unroll
    for (int i = 0; i < 5; ++i) { const int kk = lane + 64 * i; lg[i] = -INFINITY;
        if (kk < n) { const int j = lo + kk; const u32x4* kp = (const u32x4*)(U + (size_t)(b * SEQ + j) * NU + U_WAK + kvh * 64);
            float k0[8], k1[8]; unpack8(kp[0], k0); unpack8(kp[1], k1);
            const f32x4 c0 = *(const f32x4*)(rope + j * 16), c1 = *(const f32x4*)(rope + j * 16 + 4), s0 = *(const f32x4*)(rope + j * 16 + 8), s1 = *(const f32x4*)(rope + j * 16 + 12);
            float dot = 0.f, s2 = 0.f;
#pragma unroll
            for (int d = 0; d < 8; ++d) { const float cj = d < 4 ? c0[d & 3] : c1[d & 3], sj = d < 4 ? s0[d & 3] : s1[d & 3];
                const float a0 = k0[d] * sc[64 + d], a1 = k1[d] * sc[64 + 8 + d];
                dot += sc[d] * (a0 * cj - a1 * sj) + sc[8 + d] * (a1 * cj + a0 * sj); s2 += k0[d] * k0[d] + k1[d] * k1[d]; }
#pragma unroll
            for (int ch = 2; ch < 8; ++ch) { float f[8]; unpack8(kp[ch], f);
#pragma unroll
                for (int e = 0; e < 8; ++e) { dot += sc[ch * 8 + e] * sc[64 + ch * 8 + e] * f[e]; s2 += f[e] * f[e]; } }
            lg[i] = dot * rsqrtf(s2 * (1.f / 64.f) + EPS); mx = fmaxf(mx, lg[i]); } }
    mx = wmax(mx);
    float ps = 0.f;
#pragma unroll
    for (int i = 0; i < 5; ++i) { lg[i] = __expf(lg[i] - mx); ps += lg[i]; }
    const float inv = 1.0f / (wsum(ps) + __expf(sink - mx));
#pragma unroll
    for (int i = 0; i < 5; ++i) sc[128 + lane + 64 * i] = lg[i] * inv;
    LDS_WAIT();
    float o = 0.f;
    for (int kk = 0; kk < n; ++kk) o += sc[128 + kk] * bf1(U[(size_t)(b * SEQ + lo + kk) * NU + U_WAV + kvh * 64 + lane]);
    MIX[(size_t)m * DM + 512 + hq * 64 + lane] = (bf16_t)(cvtpk(o, 0.f) & 0xffffu);
    LDS_WAIT();
}

__device__ __forceinline__ void conf_slow_item(const Args& a, int l, int m, int lane) {
    const bf16_t* U = (const bf16_t*)(a.ws + WS_U); bf16_t* MIX = (bf16_t*)(a.ws + WS_MIX);
    const int t = m & 8191, c = 8 * lane;
    const float* dw = a.in[15] + (size_t)l * 31 * 512; const float* db = a.in[16] + l * 512; const float* lw = a.in[17] + l * 512; const float* lb = a.in[18] + l * 512;
    float acc[8]; { const f32x4 b0 = *(const f32x4*)(db + c), b1 = *(const f32x4*)(db + c + 4); acc[0] = b0[0]; acc[1] = b0[1]; acc[2] = b0[2]; acc[3] = b0[3]; acc[4] = b1[0]; acc[5] = b1[1]; acc[6] = b1[2]; acc[7] = b1[3]; }
    for (int k = 0; k < 31; ++k) { const int tt = t + k - 15;
        if (tt >= 0 && tt < SEQ) { const size_t mm = (size_t)(m + k - 15);
            float av[8], gv[8]; unpack8(*(const u32x4*)(U + mm * NU + U_CA + c), av); unpack8(*(const u32x4*)(U + mm * NU + U_CG + c), gv);
            const f32x4 w0 = *(const f32x4*)(dw + k * 512 + c), w1 = *(const f32x4*)(dw + k * 512 + c + 4);
#pragma unroll
            for (int e = 0; e < 8; ++e) acc[e] += (e < 4 ? w0[e & 3] : w1[e & 3]) * av[e] * sigmoidf_(gv[e]); } }
    float s = 0.f;
#pragma unroll
    for (int e = 0; e < 8; ++e) s += acc[e];
    const float mu = wsum(s) * (1.f / 512.f); float q = 0.f;
#pragma unroll
    for (int e = 0; e < 8; ++e) { acc[e] -= mu; q += acc[e] * acc[e]; }
    const float rstd = rsqrtf(wsum(q) * (1.f / 512.f) + EPS);
    const f32x4 lw0 = *(const f32x4*)(lw + c), lw1 = *(const f32x4*)(lw + c + 4), lb0 = *(const f32x4*)(lb + c), lb1 = *(const f32x4*)(lb + c + 4);
    float y[8];
#pragma unroll
    for (int e = 0; e < 8; ++e) y[e] = siluf_(acc[e] * rstd * (e < 4 ? lw0[e & 3] : lw1[e & 3]) + (e < 4 ? lb0[e & 3] : lb1[e & 3]));
    u32x4 o; o.x = cvtpk(y[0], y[1]); o.y = cvtpk(y[2], y[3]); o.z = cvtpk(y[4], y[5]); o.w = cvtpk(y[6], y[7]);
    *(u32x4*)(MIX + (size_t)m * DM + 1536 + c) = o;
}

__device__ __forceinline__ void ssd_slow_unit(const Args& a, int l, int unit, int tid) {
    const int b = unit >> 4, dir = (unit >> 3) & 1, h = unit & 7, g = h >> 2;
    const float A = -__expf(a.in[12][l * 16 + dir * 8 + h]);
    const float* XB = (const float*)(a.ws + WS_XBC); const float* DT = (const float*)(a.ws + WS_DT);
    float* YS = (float*)(a.ws + WS_YSSD) + (size_t)dir * T * 512;
    const int p = tid >> 3, q = tid & 7;
    float st[16];
#pragma unroll
    for (int i = 0; i < 16; ++i) st[i] = 0.f;
#pragma unroll 2
    for (int s = 0; s < SEQ; ++s) {
        const int t = dir ? SEQ - 1 - s : s; const size_t m = (size_t)b * SEQ + t;
        const float dtv = DT[m * 16 + dir * 8 + h];
        const float dA = __expf(dtv * A);
        const float xv = XB[m * 1024 + h * 64 + p] * dtv;
        const f32x4* bp = (const f32x4*)(XB + m * 1024 + 512 + g * 128 + 16 * q); const f32x4* cp = (const f32x4*)(XB + m * 1024 + 768 + g * 128 + 16 * q);
        float part = 0.f;
#pragma unroll
        for (int i = 0; i < 4; ++i) { const f32x4 bv = bp[i], cv = cp[i];
#pragma unroll
            for (int e = 0; e < 4; ++e) { st[4 * i + e] = dA * st[4 * i + e] + xv * bv[e]; part += st[4 * i + e] * cv[e]; } }
        part += shx(part, 1); part += shx(part, 2); part += shx(part, 4);
        if (q == 0) YS[m * 512 + h * 64 + p] = part;
    }
}

__device__ __forceinline__ void phase_mix1_slow(const Args& a, const Ctx& X, int l) {
    if (X.bid < 32) { ssd_slow_unit(a, l, X.bid, X.tid); return; }
    LAS float* sc = (LAS float*)(X.lds + X.wave * 2048);
    const int gw = (X.bid - 32) * 8 + X.wave, NGW = (X.G - 32) * 8;
    for (int it = gw; it < T * 8; it += NGW) na_slow_item(a, l, it >> 3, it & 7, sc, X.lane);
    for (int it = gw; it < T * 8; it += NGW) swa_slow_item(a, l, it >> 3, it & 7, sc, X.lane);
    for (int it = gw; it < T; it += NGW) conf_slow_item(a, l, it, X.lane);
}

__device__ __forceinline__ void phase_ssd_fin_slow(const Args& a, const Ctx& X, int l) {
    const bf16_t* U = (const bf16_t*)(a.ws + WS_U); bf16_t* MIX = (bf16_t*)(a.ws + WS_MIX); const float* XB = (const float*)(a.ws + WS_XBC);
    const float* YF = (const float*)(a.ws + WS_YSSD); const float* YB = YF + (size_t)T * 512;
    const float* nw = a.in[14] + l * 512; const float dd = a.in[13][l * 8 + (X.lane >> 3)];
    const int c = 8 * X.lane;
    for (int m = X.gw; m < T; m += X.NGW) {
        float v[8];
        { const f32x4 f0 = *(const f32x4*)(YF + (size_t)m * 512 + c), f1 = *(const f32x4*)(YF + (size_t)m * 512 + c + 4), b0 = *(const f32x4*)(YB + (size_t)m * 512 + c), b1 = *(const f32x4*)(YB + (size_t)m * 512 + c + 4);
          const f32x4 x0 = *(const f32x4*)(XB + (size_t)m * 1024 + c), x1 = *(const f32x4*)(XB + (size_t)m * 1024 + c + 4);
          float z[8]; unpack8(*(const u32x4*)(U + (size_t)m * NU + U_Z + c), z);
#pragma unroll
          for (int e = 0; e < 8; ++e) { const float y = (e < 4 ? f0[e & 3] + b0[e & 3] + x0[e & 3] * dd : f1[e & 3] + b1[e & 3] + x1[e & 3] * dd); v[e] = y * siluf_(z[e]); } }
        float ss = 0.f;
#pragma unroll
        for (int e = 0; e < 8; ++e) ss += v[e] * v[e];
        const float rstd = rsqrtf(wsum(ss) * (1.f / 512.f) + EPS);
        const f32x4 w0 = *(const f32x4*)(nw + c), w1 = *(const f32x4*)(nw + c + 4);
        u32x4 o; o.x = cvtpk(v[0] * rstd * w0[0], v[1] * rstd * w0[1]); o.y = cvtpk(v[2] * rstd * w0[2], v[3] * rstd * w0[3]); o.z = cvtpk(v[4] * rstd * w1[0], v[5] * rstd * w1[1]); o.w = cvtpk(v[6] * rstd * w1[2], v[7] * rstd * w1[3]);
        *(u32x4*)(MIX + (size_t)m * DM + 1024 + c) = o;
    }
}
typedef short v4i16_t __attribute__((ext_vector_type(4)));
__device__ __forceinline__ v4i16_t trr(const LAS unsigned char* p) { return __builtin_amdgcn_ds_read_tr16_b64_v4i16((LAS v4i16_t*)p); }
__device__ __forceinline__ bf16x8 cat8(v4i16_t lo, v4i16_t hi) { return (bf16x8){lo[0], lo[1], lo[2], lo[3], hi[0], hi[1], hi[2], hi[3]}; }
#define MFMA16(a, b, c) __builtin_amdgcn_mfma_f32_16x16x32_bf16((a), (b), (c), 0, 0, 0)

constexpr int S1_XT = 0, S1_XS = 544, S1_BT = 69632, S1_BS = 272, S1_CT = 104448, S1_CS = 272, S1_VEC = 139264;
static_assert(S1_VEC + 4 * 6 * 128 * 4 <= RMAPL_OFF, "S1 LDS map");

__device__ __forceinline__ void ssd_s1_unit(const Args& a, const Ctx& X, int l, int unit) {
    const int b = unit >> 7, c = (unit >> 1) & 63, g = unit & 1;
    const int m0 = b * SEQ + c * 128, bc = b * 64 + c;
    const bf16_t* U = (const bf16_t*)(a.ws + WS_U);
    bf16_t* XBCp = (bf16_t*)(a.ws + WS_XBC);
    float* EF = (float*)(a.ws + WS_DT);
    float* CDEC = (float*)(a.ws + WS_CDEC);
    LAS unsigned char* L = X.lds;
    LAS float* VEC = (LAS float*)(L + S1_VEC);
    {
        const int dir = X.wave >> 2, hh = X.wave & 3, h = g * 4 + hh;
        const float A = -__expf(a.in[12][l * 16 + dir * 8 + h]); const float bias = a.in[11][l * 16 + dir * 8 + h];
        const float* dtraw = (const float*)(a.ws + WS_DTRAW);
        const float d0 = softplusf_(dtraw[(size_t)(m0 + X.lane) * 16 + dir * 8 + h] + bias), d1 = softplusf_(dtraw[(size_t)(m0 + 64 + X.lane) * 16 + dir * 8 + h] + bias);
        float c0 = d0 * A, c1 = d1 * A; const float v0 = c0, v1 = c1;
#pragma unroll
        for (int o = 1; o < 64; o <<= 1) { const float t0 = shup_f(c0, o), t1 = shup_f(c1, o); if (X.lane >= o) { c0 += t0; c1 += t1; } }
        const float tot0 = shl_f(c0, 63); c1 += tot0; const float total = shl_f(c1, 63);
        LAS float* V = VEC + hh * 768;
        if (dir == 0) { V[0 * 128 + X.lane] = c0; V[0 * 128 + 64 + X.lane] = c1; V[1 * 128 + X.lane] = d0; V[1 * 128 + 64 + X.lane] = d1;
            V[4 * 128 + X.lane] = d0 * __expf(total - c0); V[4 * 128 + 64 + X.lane] = d1 * __expf(total - c1);
            EF[(size_t)(m0 + X.lane) * 16 + h] = __expf(c0); EF[(size_t)(m0 + 64 + X.lane) * 16 + h] = __expf(c1); }
        else { const float x0 = c0 - v0, x1 = c1 - v1;
            V[2 * 128 + X.lane] = x0; V[2 * 128 + 64 + X.lane] = x1; V[3 * 128 + X.lane] = d0; V[3 * 128 + 64 + X.lane] = d1;
            V[5 * 128 + X.lane] = d0 * __expf(x0); V[5 * 128 + 64 + X.lane] = d1 * __expf(x1);
            EF[(size_t)(m0 + X.lane) * 16 + 8 + h] = __expf(total - x0); EF[(size_t)(m0 + 64 + X.lane) * 16 + 8 + h] = __expf(total - x1); }
        if (X.lane == 0) CDEC[(dir * 128 + bc) * 8 + h] = __expf(total);
    }
    {
        const int cg = X.tid & 63, rb = X.tid >> 6;
        const int sc = cg < 32 ? g * 256 + 8 * cg : (cg < 48 ? 512 + g * 128 + 8 * (cg - 32) : 768 + g * 128 + 8 * (cg - 48));
        const float* cw = a.in[9] + (size_t)l * 5 * 1024 + sc; const float* cb = a.in[10] + (size_t)l * 1024 + sc;
        float w[5][8], bs[8];
#pragma unroll
        for (int k = 0; k < 5; ++k) { const f32x4 w0 = *(const f32x4*)(cw + k * 1024), w1 = *(const f32x4*)(cw + k * 1024 + 4); w[k][0] = w0[0]; w[k][1] = w0[1]; w[k][2] = w0[2]; w[k][3] = w0[3]; w[k][4] = w1[0]; w[k][5] = w1[1]; w[k][6] = w1[2]; w[k][7] = w1[3]; }
        { const f32x4 b0 = *(const f32x4*)cb, b1 = *(const f32x4*)(cb + 4); bs[0] = b0[0]; bs[1] = b0[1]; bs[2] = b0[2]; bs[3] = b0[3]; bs[4] = b1[0]; bs[5] = b1[1]; bs[6] = b1[2]; bs[7] = b1[3]; }
        LAS unsigned char* dstl = cg < 32 ? L + S1_XT + cg * 16 : (cg < 48 ? L + S1_BT + (cg - 32) * 16 : L + S1_CT + (cg - 48) * 16);
        const int dstride = cg < 32 ? S1_XS : S1_BS;
        const int t0 = c * 128 + rb * 16;
        u32x4 raw[20];
#pragma unroll
        for (int i = 0; i < 20; ++i) { const int tt = t0 + i - 2; raw[i] = (u32x4){0u, 0u, 0u, 0u}; if (tt >= 0 && tt < SEQ) raw[i] = *(const u32x4*)(U + (size_t)(b * SEQ + tt) * NU + U_XBC + sc); }
#pragma unroll
        for (int i = 0; i < 16; ++i) {
            float acc[8];
#pragma unroll
            for (int e = 0; e < 8; ++e) acc[e] = bs[e];
#pragma unroll
            for (int k = 0; k < 5; ++k) { float f[8]; unpack8(raw[i + k], f);
#pragma unroll
                for (int e = 0; e < 8; ++e) acc[e] += w[k][e] * f[e]; }
            u32x4 o; o.x = cvtpk(siluf_(acc[0]), siluf_(acc[1])); o.y = cvtpk(siluf_(acc[2]), siluf_(acc[3])); o.z = cvtpk(siluf_(acc[4]), siluf_(acc[5])); o.w = cvtpk(siluf_(acc[6]), siluf_(acc[7]));
            *(LAS u32x4*)(dstl + (rb * 16 + i) * dstride) = o;
            if (cg < 32 || cg >= 48) *(u32x4*)(XBCp + (size_t)(m0 + rb * 16 + i) * 1024 + sc) = o;
        }
    }
    LBAR();
    const int fr = X.lane & 15, gq = X.lane >> 4;
    {
        const int w = X.wave, lrow = 16 * w + fr;
        bf16x8 cfr[4];
#pragma unroll
        for (int ks = 0; ks < 4; ++ks) cfr[ks] = *(const LAS bf16x8*)(L + S1_CT + lrow * S1_CS + (32 * ks + 8 * gq) * 2);
        f32x4 d[8];
#pragma unroll
        for (int st = 0; st < 8; ++st) { d[st] = (f32x4){0.f, 0.f, 0.f, 0.f};
#pragma unroll
            for (int ks = 0; ks < 4; ++ks) { const bf16x8 bfr = *(const LAS bf16x8*)(L + S1_BT + (16 * st + fr) * S1_BS + (32 * ks + 8 * gq) * 2); d[st] = MFMA16(bfr, cfr[ks], d[st]); } }
        bf16_t* YD = (bf16_t*)(a.ws + WS_YSSD);
#pragma unroll 1
        for (int hh = 0; hh < 4; ++hh) {
            const LAS float* V = VEC + hh * 768;
            const float cfl = V[lrow], cbxl = V[2 * 128 + lrow];
            f32x4 yacc[4];
#pragma unroll
            for (int pt = 0; pt < 4; ++pt) yacc[pt] = (f32x4){0.f, 0.f, 0.f, 0.f};
#pragma unroll
            for (int kk = 0; kk < 4; ++kk) {
                float wv[8];
#pragma unroll
                for (int hf = 0; hf < 2; ++hf) { const int st = 2 * kk + hf, s0 = 16 * st + 4 * gq;
                    const f32x4 cfs = *(const LAS f32x4*)(V + s0), dt0s = *(const LAS f32x4*)(V + 128 + s0), cbxs = *(const LAS f32x4*)(V + 256 + s0), dt1s = *(const LAS f32x4*)(V + 384 + s0);
#pragma unroll
                    for (int r = 0; r < 4; ++r) { const int s = s0 + r; float ww = 0.f;
                        if (st < w) ww = __expf(cfl - cfs[r]) * dt0s[r];
                        else if (st > w) ww = __expf(cbxs[r] - cbxl) * dt1s[r];
                        else { if (s <= lrow) ww = __expf(cfl - cfs[r]) * dt0s[r]; if (s >= lrow) ww += __expf(cbxs[r] - cbxl) * dt1s[r]; }
                        wv[hf * 4 + r] = d[st][r] * ww; } }
                u32x4 wp; wp.x = cvtpk(wv[0], wv[1]); wp.y = cvtpk(wv[2], wv[3]); wp.z = cvtpk(wv[4], wv[5]); wp.w = cvtpk(wv[6], wv[7]);
                const bf16x8 wfr = __builtin_bit_cast(bf16x8, wp);
#pragma unroll
                for (int pt = 0; pt < 4; ++pt) { const LAS unsigned char* xp = L + S1_XT + (32 * kk + 4 * gq + (fr >> 2)) * S1_XS + (hh * 64 + 16 * pt + 4 * (fr & 3)) * 2;
                    const bf16x8 xfr = cat8(trr(xp), trr(xp + 16 * S1_XS)); yacc[pt] = MFMA16(xfr, wfr, yacc[pt]); }
            }
#pragma unroll
            for (int pt = 0; pt < 4; ++pt) { u32x2 o; o.x = cvtpk(yacc[pt][0], yacc[pt][1]); o.y = cvtpk(yacc[pt][2], yacc[pt][3]); *(u32x2*)(YD + (size_t)(m0 + lrow) * 512 + (g * 4 + hh) * 64 + 16 * pt + 4 * gq) = o; }
        }
    }
    {
        const int dir = X.wave >> 2, hh = X.wave & 3, h = g * 4 + hh;
        const LAS float* WV = VEC + hh * 768 + (dir ? 5 : 4) * 128;
        bf16x8 xs[4][4];
#pragma unroll
        for (int ks = 0; ks < 4; ++ks) { const f32x4 w0 = *(const LAS f32x4*)(WV + 32 * ks + 8 * gq), w1 = *(const LAS f32x4*)(WV + 32 * ks + 8 * gq + 4);
#pragma unroll
            for (int pt = 0; pt < 4; ++pt) { const LAS unsigned char* xp = L + S1_XT + (32 * ks + 8 * gq + (fr >> 2)) * S1_XS + (hh * 64 + 16 * pt + 4 * (fr & 3)) * 2;
                const v4i16_t lo = trr(xp), hi = trr(xp + 4 * S1_XS);
                const u32x2 lw = __builtin_bit_cast(u32x2, lo), hw = __builtin_bit_cast(u32x2, hi);
                u32x4 o; o.x = cvtpk(bflo(lw.x) * w0[0], bfhi(lw.x) * w0[1]); o.y = cvtpk(bflo(lw.y) * w0[2], bfhi(lw.y) * w0[3]); o.z = cvtpk(bflo(hw.x) * w1[0], bfhi(hw.x) * w1[1]); o.w = cvtpk(bflo(hw.y) * w1[2], bfhi(hw.y) * w1[3]);
                xs[ks][pt] = __builtin_bit_cast(bf16x8, o); } }
        bf16_t* ST = (bf16_t*)(a.ws + WS_STATE) + ((size_t)((dir * 128 + bc) * 8 + h)) * 64 * 128;
#pragma unroll 1
        for (int half = 0; half < 2; ++half) {
            f32x4 acc[4][4];
#pragma unroll
            for (int nt = 0; nt < 4; ++nt)
#pragma unroll
                for (int pt = 0; pt < 4; ++pt) acc[nt][pt] = (f32x4){0.f, 0.f, 0.f, 0.f};
#pragma unroll
            for (int ks = 0; ks < 4; ++ks) {
                bf16x8 af[4];
#pragma unroll
                for (int nt = 0; nt < 4; ++nt) { const LAS unsigned char* bp = L + S1_BT + (32 * ks + 8 * gq + (fr >> 2)) * S1_BS + (16 * (4 * half + nt) + 4 * (fr & 3)) * 2; af[nt] = cat8(trr(bp), trr(bp + 4 * S1_BS)); }
#pragma unroll
                for (int nt = 0; nt < 4; ++nt)
#pragma unroll
                    for (int pt = 0; pt < 4; ++pt) acc[nt][pt] = MFMA16(af[nt], xs[ks][pt], acc[nt][pt]);
            }
#pragma unroll
            for (int nt = 0; nt < 4; ++nt)
#pragma unroll
                for (int pt = 0; pt < 4; ++pt) { u32x2 o; o.x = cvtpk(acc[nt][pt][0], acc[nt][pt][1]); o.y = cvtpk(acc[nt][pt][2], acc[nt][pt][3]); *(u32x2*)(ST + (size_t)(16 * pt + fr) * 128 + 16 * (4 * half + nt) + 4 * gq) = o; }
        }
    }
    LBAR();
}

__device__ __forceinline__ void phase_ssd_scan(const Args& a, const Ctx& X) {
    const bf16_t* ST = (const bf16_t*)(a.ws + WS_STATE); const float* CDEC = (const float*)(a.ws + WS_CDEC); bf16_t* PREV = (bf16_t*)(a.ws + WS_PREV);
#pragma unroll 1
    for (int w = X.gw; w < 2 * 2 * 8 * 64; w += X.NGW) {
        const int p = w & 63, h = (w >> 6) & 7, b = (w >> 9) & 1, dir = w >> 10;
        const int c0 = dir ? 63 : 0, cs = dir ? -1 : 1;
        const size_t cstr = (size_t)8 * 64 * 128;
        const size_t base = ((size_t)((dir * 128 + b * 64) * 8 + h) * 64 + p) * 128 + 2 * X.lane;
        const int dbase = (dir * 128 + b * 64) * 8 + h;
        unsigned swA[16], swB[16]; float dcA[16], dcB[16];
        float r0 = 0.f, r1 = 0.f;
#define SCAN_LOAD(sw, dc, k) _Pragma("unroll") for (int j = 0; j < 16; ++j) { const int c = c0 + cs * (16 * (k) + j); sw[j] = *(const unsigned*)(ST + base + (size_t)c * cstr); dc[j] = CDEC[dbase + c * 8]; }
#define SCAN_RUN(sw, dc, k) _Pragma("unroll") for (int j = 0; j < 16; ++j) { const int c = c0 + cs * (16 * (k) + j); *(unsigned*)(PREV + base + (size_t)c * cstr) = cvtpk(r0, r1); r0 = r0 * dc[j] + bflo(sw[j]); r1 = r1 * dc[j] + bfhi(sw[j]); }
        SCAN_LOAD(swA, dcA, 0);
        SCAN_LOAD(swB, dcB, 1);
        SCAN_RUN(swA, dcA, 0);
        SCAN_LOAD(swA, dcA, 2);
        SCAN_RUN(swB, dcB, 1);
        SCAN_LOAD(swB, dcB, 3);
        SCAN_RUN(swA, dcA, 2);
        SCAN_RUN(swB, dcB, 3);
#undef SCAN_LOAD
#undef SCAN_RUN
    }
}

__device__ __forceinline__ void ssd_s3_unit(const Args& a, const Ctx& X, int l, int unit) {
    const int b = unit >> 7, c = (unit >> 1) & 63, lh = unit & 1, h = X.wave, g = h >> 2;
    const int m0 = b * SEQ + c * 128 + 64 * lh, bc = b * 64 + c;
    const int fr = X.lane & 15, gq = X.lane >> 4;
    const bf16_t* XBCp = (const bf16_t*)(a.ws + WS_XBC); const bf16_t* PREV = (const bf16_t*)(a.ws + WS_PREV); const bf16_t* U = (const bf16_t*)(a.ws + WS_U);
    const float* EF = (const float*)(a.ws + WS_DT); const bf16_t* YD = (const bf16_t*)(a.ws + WS_YSSD); bf16_t* MIX = (bf16_t*)(a.ws + WS_MIX);
    f32x4 accf[4][4];
#pragma unroll
    for (int lt = 0; lt < 4; ++lt)
#pragma unroll
        for (int pt = 0; pt < 4; ++pt) accf[lt][pt] = (f32x4){0.f, 0.f, 0.f, 0.f};
    float esc[2][4];
#pragma unroll
    for (int lt = 0; lt < 4; ++lt) { const size_t m = (size_t)(m0 + 16 * lt + fr); esc[0][lt] = EF[m * 16 + h]; esc[1][lt] = EF[m * 16 + 8 + h]; }
    u32x4 cw[2][4]; bf16x8 pf[2][4];
#define S3_LOADC(buf, ks) do { _Pragma("unroll") for (int lt = 0; lt < 4; ++lt) cw[buf][lt] = *(const u32x4*)(XBCp + (size_t)(m0 + 16 * lt + fr) * 1024 + 768 + g * 128 + 32 * (ks) + 8 * gq); } while (0)
#define S3_LOADP(buf, ks, dir) do { const bf16_t* pp = PREV + ((size_t)(((dir) * 128 + bc) * 8 + h) * 64 + fr) * 128 + 8 * gq + 32 * (ks); \
        _Pragma("unroll") for (int pt = 0; pt < 4; ++pt) pf[buf][pt] = *(const bf16x8*)(pp + (size_t)(16 * pt) * 128); } while (0)
    S3_LOADC(0, 0); S3_LOADP(0, 0, 0); __builtin_amdgcn_sched_barrier(0);
#pragma unroll
    for (int s = 0; s < 8; ++s) { const int ks = s >> 1, dir = s & 1;
        if (s < 7) { if ((s & 1) == 0) S3_LOADP(1, ks, 1); else { S3_LOADP(0, ks + 1, 0); if ((ks & 1) == 0) S3_LOADC(1, ks + 1); else S3_LOADC(0, ks + 1); } }
        __builtin_amdgcn_sched_barrier(0);
        bf16x8 cs[4];
#pragma unroll
        for (int lt = 0; lt < 4; ++lt) { float f[8]; unpack8(cw[ks & 1][lt], f); const float e = esc[dir][lt];
            u32x4 o; o.x = cvtpk(f[0] * e, f[1] * e); o.y = cvtpk(f[2] * e, f[3] * e); o.z = cvtpk(f[4] * e, f[5] * e); o.w = cvtpk(f[6] * e, f[7] * e); cs[lt] = __builtin_bit_cast(bf16x8, o); }
#pragma unroll
        for (int pt = 0; pt < 4; ++pt)
#pragma unroll
            for (int lt = 0; lt < 4; ++lt) accf[lt][pt] = MFMA16(pf[s & 1][pt], cs[lt], accf[lt][pt]);
    }
#undef S3_LOADC
#undef S3_LOADP
    const float dd = a.in[13][l * 8 + h];
    const float* nw = a.in[14] + l * 512;
    f32x4 nwv[4];
#pragma unroll
    for (int pt = 0; pt < 4; ++pt) nwv[pt] = *(const f32x4*)(nw + h * 64 + 16 * pt + 4 * gq);
    LAS float* red = (LAS float*)X.lds;
    u32x2 ep[2][4][3];
#define S3_EPLOAD(buf, lt) do { const size_t m_ = (size_t)(m0 + 16 * (lt) + fr); _Pragma("unroll") for (int pt = 0; pt < 4; ++pt) { const int ch = h * 64 + 16 * pt + 4 * gq; \
        ep[buf][pt][0] = *(const u32x2*)(YD + m_ * 512 + ch); ep[buf][pt][1] = *(const u32x2*)(XBCp + m_ * 1024 + ch); ep[buf][pt][2] = *(const u32x2*)(U + m_ * NU + U_Z + ch); } } while (0)
    S3_EPLOAD(0, 0); __builtin_amdgcn_sched_barrier(0);
#pragma unroll
    for (int lt = 0; lt < 4; ++lt) { float ss = 0.f;
        if (lt < 3) { if ((lt & 1) == 0) S3_EPLOAD(1, lt + 1); else S3_EPLOAD(0, lt + 1); }
        __builtin_amdgcn_sched_barrier(0);
#pragma unroll
        for (int pt = 0; pt < 4; ++pt) {
            const u32x2 yw = ep[lt & 1][pt][0], xw = ep[lt & 1][pt][1], zw = ep[lt & 1][pt][2]; const f32x4 yd = (f32x4){bflo(yw.x), bfhi(yw.x), bflo(yw.y), bfhi(yw.y)};
            const float xv[4] = {bflo(xw.x), bfhi(xw.x), bflo(xw.y), bfhi(xw.y)}, zv[4] = {bflo(zw.x), bfhi(zw.x), bflo(zw.y), bfhi(zw.y)};
            f32x4 v;
#pragma unroll
            for (int r = 0; r < 4; ++r) { const float val = accf[lt][pt][r] + yd[r] + xv[r] * dd; v[r] = val * siluf_(zv[r]); ss += v[r] * v[r]; }
            accf[lt][pt] = v; }
        ss += shx(ss, 16); ss += shx(ss, 32);
        if (gq == 0) red[(16 * lt + fr) * 8 + h] = ss;
        asm volatile("" ::: "memory"); }
#undef S3_EPLOAD
    LBAR();
#pragma unroll
    for (int lt = 0; lt < 4; ++lt) { const size_t m = (size_t)(m0 + 16 * lt + fr);
        const f32x4 r0 = *(const LAS f32x4*)(red + (16 * lt + fr) * 8), r1 = *(const LAS f32x4*)(red + (16 * lt + fr) * 8 + 4);
        const float rstd = rsqrtf(((r0[0] + r0[1]) + (r0[2] + r0[3]) + (r1[0] + r1[1]) + (r1[2] + r1[3])) * (1.f / 512.f) + EPS);
#pragma unroll
        for (int pt = 0; pt < 4; ++pt) { const int ch = h * 64 + 16 * pt + 4 * gq; const f32x4 w = nwv[pt]; const f32x4 v = accf[lt][pt];
            u32x2 o; o.x = cvtpk(v[0] * rstd * w[0], v[1] * rstd * w[1]); o.y = cvtpk(v[2] * rstd * w[2], v[3] * rstd * w[3]);
            *(u32x2*)(MIX + m * DM + 1024 + ch) = o; } }
    LBAR();
}

constexpr int AT_RS = 144;

__device__ __forceinline__ float rope_frev(int e) { return e == 0 ? 0.15915494309189535f : e == 1 ? 0.03086376340470123f : e == 2 ? 0.0059851857127137054f : e == 3 ? 0.001160663641240061f : e == 4 ? 0.00022507907903927653f : e == 5 ? 4.3647952792802891e-05f : e == 6 ? 8.4643308082414014e-06f : 1.6414262627950345e-06f; }
__device__ __forceinline__ void rope_cs(int pos, float frev, float& c, float& s) { const float r = (float)pos * frev, fr = r - __builtin_floorf(r); c = __builtin_amdgcn_cosf(fr); s = __builtin_amdgcn_sinf(fr); }

constexpr int SW_ROWS = 304, SW_KT = 0, SW_VT = SW_ROWS * AT_RS;
struct SwaPre { u32x4 kw[5], vw[5], q0, q1; };
__device__ __forceinline__ void swa_issue(const Args& a, const Ctx& X, int unit, SwaPre& P) {
    const int b = unit >> 9, kvh = (unit >> 8) & 1, qb = unit & 255, q0 = 32 * qb, kbase = q0 - 128, sub = X.tid & 7;
    const bf16_t* U = (const bf16_t*)(a.ws + WS_U);
#pragma unroll
    for (int i = 0; i < 5; ++i) { const int it = X.tid + 512 * i, row = it >> 3, pos = kbase + row; const bool ok = it < SW_ROWS * 8 && pos >= 0 && pos < SEQ;
        P.kw[i] = (u32x4){0u, 0u, 0u, 0u}; P.vw[i] = (u32x4){0u, 0u, 0u, 0u};
        if (ok) { const bf16_t* p = U + (size_t)(b * SEQ + pos) * NU + kvh * 64 + 8 * sub; P.kw[i] = *(const u32x4*)(p + U_WAK); P.vw[i] = *(const u32x4*)(p + U_WAV); } }
    const int hq = kvh * 4 + (X.wave >> 1), qt = X.wave & 1, posq = q0 + 16 * qt + (X.lane & 15), gq = X.lane >> 4;
    const bf16_t* qp = U + (size_t)(b * SEQ + posq) * NU + U_WAQ + hq * 64 + 8 * gq;
    P.q0 = *(const u32x4*)qp; P.q1 = *(const u32x4*)(qp + 32);
}
__device__ __forceinline__ void swa_fast_unit(const Args& a, const Ctx& X, int l, int unit, SwaPre& P, int next_unit) {
    const int b = unit >> 9, kvh = (unit >> 8) & 1, qb = unit & 255, q0 = 32 * qb, kbase = q0 - 128;
    bf16_t* MIX = (bf16_t*)(a.ws + WS_MIX);
    LAS unsigned char* L = X.lds;
    {
        const float* knw = a.in[7] + l * 64; const int sub = X.tid & 7;
        const f32x4 w0 = *(const f32x4*)(knw + 8 * sub), w1 = *(const f32x4*)(knw + 8 * sub + 4);
#pragma unroll
        for (int i = 0; i < 5; ++i) { const int it = X.tid + 512 * i, row = it >> 3;
            float f[8]; unpack8(P.kw[i], f); float ss = 0.f;
#pragma unroll
            for (int e = 0; e < 8; ++e) ss += f[e] * f[e];
            ss += shx(ss, 1); ss += shx(ss, 2); ss += shx(ss, 4);
            const float rstd = rsqrtf(ss * (1.f / 64.f) + EPS);
#pragma unroll
            for (int e = 0; e < 8; ++e) f[e] *= rstd * (e < 4 ? w0[e & 3] : w1[e & 3]);
            u32x4 o; o.x = cvtpk(f[0], f[1]); o.y = cvtpk(f[2], f[3]); o.z = cvtpk(f[4], f[5]); o.w = cvtpk(f[6], f[7]);
            if (it < SW_ROWS * 8) { *(LAS u32x4*)(L + SW_KT + row * AT_RS + sub * 16) = o; *(LAS u32x4*)(L + SW_VT + row * AT_RS + sub * 16) = P.vw[i]; } }
    }
    const u32x4 qr0 = P.q0, qr1 = P.q1;
    LBAR();
    {
        const int e = X.tid & 7; const float frev = rope_frev(e);
#pragma unroll
        for (int i = 0; i < 5; ++i) { const int it = X.tid + 512 * i, row = it >> 3;
            if (it < SW_ROWS * 8) { LAS bf16_t* kp = (LAS bf16_t*)(L + SW_KT + row * AT_RS) + e; const float x1 = bf1(kp[0]), x2 = bf1(kp[8]); float cs, sn; rope_cs(kbase + row, frev, cs, sn);
                const unsigned o = cvtpk(x1 * cs - x2 * sn, x2 * cs + x1 * sn); kp[0] = (bf16_t)(o & 0xffffu); kp[8] = (bf16_t)(o >> 16); } }
    }
    LBAR();
    const int fr = X.lane & 15, gq = X.lane >> 4;
    const int hq = kvh * 4 + (X.wave >> 1), qt = X.wave & 1, q1 = q0 + 16 * qt, posq = q1 + fr;
    const size_t m = (size_t)(b * SEQ + posq);
    bf16x8 qf[2];
    {
        const float* qnw = a.in[6] + l * 64;
        float q[2][8]; unpack8(qr0, q[0]); unpack8(qr1, q[1]);
        float ss = 0.f;
#pragma unroll
        for (int e = 0; e < 8; ++e) ss += q[0][e] * q[0][e] + q[1][e] * q[1][e];
        ss += shx(ss, 16); ss += shx(ss, 32);
        const float rstd = rsqrtf(ss * (1.f / 64.f) + EPS);
#pragma unroll
        for (int ks = 0; ks < 2; ++ks) { const f32x4 w0 = *(const f32x4*)(qnw + 32 * ks + 8 * gq), w1 = *(const f32x4*)(qnw + 32 * ks + 8 * gq + 4);
#pragma unroll
            for (int e = 0; e < 8; ++e) q[ks][e] *= rstd * (e < 4 ? w0[e & 3] : w1[e & 3]); }
#pragma unroll
        for (int e = 0; e < 8; ++e) { const float pr = shx(q[0][e], 16); float cj, sj; rope_cs(posq, rope_frev(e), cj, sj);
            q[0][e] = gq == 0 ? q[0][e] * cj - pr * sj : (gq == 1 ? q[0][e] * cj + pr * sj : q[0][e]); }
#pragma unroll
        for (int ks = 0; ks < 2; ++ks) { u32x4 o; o.x = cvtpk(q[ks][0] * 0.125f, q[ks][1] * 0.125f); o.y = cvtpk(q[ks][2] * 0.125f, q[ks][3] * 0.125f); o.z = cvtpk(q[ks][4] * 0.125f, q[ks][5] * 0.125f); o.w = cvtpk(q[ks][6] * 0.125f, q[ks][7] * 0.125f);
            qf[ks] = __builtin_bit_cast(bf16x8, o); }
    }
    const float sink = a.in[8][l * 8 + hq];
    if (next_unit >= 0) swa_issue(a, X, next_unit, P);
    f32x4 st[18];
#pragma unroll
    for (int t = 0; t < 18; ++t) { st[t] = (f32x4){0.f, 0.f, 0.f, 0.f};
#pragma unroll
        for (int ks = 0; ks < 2; ++ks) { const bf16x8 kf = *(const LAS bf16x8*)(L + SW_KT + (16 * (qt + t) + fr) * AT_RS + (32 * ks + 8 * gq) * 2); st[t] = MFMA16(kf, qf[ks], st[t]); } }
    float mx = sink;
#pragma unroll
    for (int t = 0; t < 18; ++t)
#pragma unroll
        for (int r = 0; r < 4; ++r) { const int rel = 16 * t + 4 * gq + r, posk = kbase + 16 * qt + rel; const bool ok = rel >= fr && rel <= 256 + fr && posk >= 0 && posk < SEQ;
            st[t][r] = ok ? st[t][r] : -INFINITY; mx = fmaxf(mx, st[t][r]); }
    mx = fmaxf(mx, shx(mx, 16)); mx = fmaxf(mx, shx(mx, 32));
    float sum = 0.f;
#pragma unroll
    for (int t = 0; t < 18; ++t)
#pragma unroll
        for (int r = 0; r < 4; ++r) { st[t][r] = __expf(st[t][r] - mx); sum += st[t][r]; }
    sum += shx(sum, 16); sum += shx(sum, 32);
    const float inv = 1.0f / (sum + __expf(sink - mx));
    f32x4 o[4];
#pragma unroll
    for (int dt = 0; dt < 4; ++dt) o[dt] = (f32x4){0.f, 0.f, 0.f, 0.f};
#pragma unroll
    for (int kk = 0; kk < 9; ++kk) {
        u32x4 pw; pw.x = cvtpk(st[2 * kk][0], st[2 * kk][1]); pw.y = cvtpk(st[2 * kk][2], st[2 * kk][3]); pw.z = cvtpk(st[2 * kk + 1][0], st[2 * kk + 1][1]); pw.w = cvtpk(st[2 * kk + 1][2], st[2 * kk + 1][3]);
        const bf16x8 pf = __builtin_bit_cast(bf16x8, pw);
#pragma unroll
        for (int dt = 0; dt < 4; ++dt) { const LAS unsigned char* vp = L + SW_VT + (16 * (qt + 2 * kk) + 4 * gq + (fr >> 2)) * AT_RS + (16 * dt + 4 * (fr & 3)) * 2;
            const bf16x8 vf = cat8(trr(vp), trr(vp + 16 * AT_RS)); o[dt] = MFMA16(vf, pf, o[dt]); }
    }
#pragma unroll
    for (int dt = 0; dt < 4; ++dt) { u32x2 w; w.x = cvtpk(o[dt][0] * inv, o[dt][1] * inv); w.y = cvtpk(o[dt][2] * inv, o[dt][3] * inv);
        *(u32x2*)(MIX + m * DM + 512 + hq * 64 + 16 * dt + 4 * gq) = w; }
    LBAR();
}

constexpr int NA_KT = 0, NA_VT = 576 * 128, NA_RK = 2 * 576 * 128, NA_BIAS = NA_RK + 576 * 4;
static_assert(NA_BIAS + 465 * 4 <= LDSCTL_OFF, "NA LDS map");
__device__ __forceinline__ int na_off(int row, int chunk) { return row * 128 + ((chunk ^ (row & 7)) << 4); }
struct NaPre { u32x4 kv[9], vv[9], q0, q1; };
template <int PART>
__device__ __forceinline__ void na_issue(const Args& a, const Ctx& X, int unit, NaPre& P) {
    const int b = unit >> 9, rp = (unit >> 3) & 63, h = unit & 7, vr0 = __builtin_amdgcn_readfirstlane(min(max(2 * rp - 4, 0), 120));
    const bf16_t* U = (const bf16_t*)(a.ws + WS_U);
#pragma unroll
    for (int i = 0; i < 9; ++i) { const int it = X.tid + 512 * i, key = it >> 3, sub = it & 7, kr = vr0 + (key >> 6);
        if (PART == 0) P.kv[i] = (u32x4){0u, 0u, 0u, 0u}; else P.vv[i] = (u32x4){0u, 0u, 0u, 0u};
        if (kr < 128) { const bf16_t* p = U + (size_t)(b * SEQ + kr * 64 + (key & 63)) * NU + h * 64 + 8 * sub; if (PART == 0) P.kv[i] = *(const u32x4*)(p + U_NAK); else P.vv[i] = *(const u32x4*)(p + U_NAV); } }
    if (PART == 0) {
        const int qrow = 2 * rp + (X.wave >> 2), c = 16 * (X.wave & 3) + (X.lane & 15), gq = X.lane >> 4;
        const bf16_t* qp = U + (size_t)(b * SEQ + qrow * 64 + c) * NU + U_NAQ + h * 64 + 8 * gq;
        P.q0 = *(const u32x4*)qp; P.q1 = *(const u32x4*)(qp + 32); }
}
__device__ __forceinline__ void na_fast_unit(const Args& a, const Ctx& X, int l, int unit, NaPre& P, int next_unit) {
    const int b = unit >> 9, rp = (unit >> 3) & 63, h = unit & 7;
    bf16_t* MIX = (bf16_t*)(a.ws + WS_MIX);
    LAS unsigned char* L = X.lds; LAS float* BIAS = (LAS float*)(L + NA_BIAS); LAS float* RK = (LAS float*)(L + NA_RK);
    const int vr0 = __builtin_amdgcn_readfirstlane(min(max(2 * rp - 4, 0), 120));
#pragma unroll
    for (int i = 0; i < 9; ++i) { const int it = X.tid + 512 * i, key = it >> 3, sub = it & 7;
        float f[8]; unpack8(P.kv[i], f); float ss = 0.f;
#pragma unroll
        for (int e = 0; e < 8; ++e) ss += f[e] * f[e];
        ss += shx(ss, 1); ss += shx(ss, 2); ss += shx(ss, 4);
        if (sub == 0) RK[key] = rsqrtf(ss * (1.f / 64.f) + EPS);
        const int so = (X.tid >> 3) * 128 + ((sub ^ ((X.tid >> 3) & 7)) << 4) + i * 8192;
        *(LAS u32x4*)(L + NA_KT + so) = P.kv[i]; *(LAS u32x4*)(L + NA_VT + so) = P.vv[i]; }
    { const float* rpb = a.in[5] + (size_t)(l * 8 + h) * 465; if (X.tid < 465) BIAS[X.tid] = rpb[X.tid]; }
    const u32x4 qr0 = P.q0, qr1 = P.q1;
    const int fr = X.lane & 15, gq = X.lane >> 4;
    const int qrow = 2 * rp + (X.wave >> 2), cb = 16 * (X.wave & 3), r0 = __builtin_amdgcn_readfirstlane(min(max(qrow - 4, 0), 120)), wsc = __builtin_amdgcn_readfirstlane(min(max(cb - 8, 0), 32));
    const int c = cb + fr, c0 = min(max(c - 8, 0), 48);
    const size_t m = (size_t)(b * SEQ + qrow * 64 + c);
    bf16x8 qf[2];
    {
        const float* qnw = a.in[3] + l * 64; const float* knw = a.in[4] + l * 64;
        float q[2][8]; unpack8(qr0, q[0]); unpack8(qr1, q[1]);
        float ss = 0.f;
#pragma unroll
        for (int e = 0; e < 8; ++e) ss += q[0][e] * q[0][e] + q[1][e] * q[1][e];
        ss += shx(ss, 16); ss += shx(ss, 32);
        const float rstd = rsqrtf(ss * (1.f / 64.f) + EPS) * 0.125f;
#pragma unroll
        for (int ks = 0; ks < 2; ++ks) { const f32x4 w0 = *(const f32x4*)(qnw + 32 * ks + 8 * gq), w1 = *(const f32x4*)(qnw + 32 * ks + 8 * gq + 4), k0 = *(const f32x4*)(knw + 32 * ks + 8 * gq), k1 = *(const f32x4*)(knw + 32 * ks + 8 * gq + 4);
#pragma unroll
            for (int e = 0; e < 8; ++e) q[ks][e] *= rstd * (e < 4 ? w0[e & 3] * k0[e & 3] : w1[e & 3] * k1[e & 3]);
            u32x4 o; o.x = cvtpk(q[ks][0], q[ks][1]); o.y = cvtpk(q[ks][2], q[ks][3]); o.z = cvtpk(q[ks][4], q[ks][5]); o.w = cvtpk(q[ks][6], q[ks][7]); qf[ks] = __builtin_bit_cast(bf16x8, o); }
    }
    LBAR();
    if (next_unit >= 0) na_issue<0>(a, X, next_unit, P);
    int ksw[2];
#pragma unroll
    for (int ks = 0; ks < 2; ++ks) ksw[ks] = fr * 128 + (((4 * ks + gq) ^ (fr & 7)) << 4);
    f32x4 st[16]; float mx = -INFINITY;
#pragma unroll
    for (int t = 0; t < 16; ++t) { const int kr = r0 + (t >> 1), kc0 = wsc + 16 * (t & 1), keyb = (kr - vr0) * 64 + kc0;
        f32x4 s = (f32x4){0.f, 0.f, 0.f, 0.f};
#pragma unroll
        for (int ks = 0; ks < 2; ++ks) { const bf16x8 kf = *(const LAS bf16x8*)(L + NA_KT + keyb * 128 + ksw[ks]); s = MFMA16(kf, qf[ks], s); }
        const f32x4 rk = *(const LAS f32x4*)(RK + keyb + 4 * gq);
#pragma unroll
        for (int r = 0; r < 4; ++r) { const int kcol = kc0 + 4 * gq + r; const bool ok = kcol >= c0 && kcol < c0 + 16;
            const int bi = (kr - qrow + 7) * 31 + (kcol - c + 15);
            const float v = ok ? s[r] * rk[r] + BIAS[ok ? bi : 0] : -INFINITY; s[r] = v; mx = fmaxf(mx, v); }
        st[t] = s; if ((t & 3) == 3) __builtin_amdgcn_sched_barrier(0); }
    mx = fmaxf(mx, shx(mx, 16)); mx = fmaxf(mx, shx(mx, 32));
    float sum = 0.f;
#pragma unroll
    for (int t = 0; t < 16; ++t)
#pragma unroll
        for (int r = 0; r < 4; ++r) { st[t][r] = __expf(st[t][r] - mx); sum += st[t][r]; }
    sum += shx(sum, 16); sum += shx(sum, 32);
    const float inv = 1.0f / sum;
    if (next_unit >= 0) na_issue<1>(a, X, next_unit, P);
    f32x4 o[4]; int vsw[4];
#pragma unroll
    for (int dt = 0; dt < 4; ++dt) { o[dt] = (f32x4){0.f, 0.f, 0.f, 0.f}; const int rl = 4 * gq + (fr >> 2); vsw[dt] = rl * 128 + (((2 * dt + ((fr & 3) >> 1)) ^ (rl & 7)) << 4) + 8 * (fr & 1); }
#pragma unroll
    for (int kk = 0; kk < 8; ++kk) {
        u32x4 pw; pw.x = cvtpk(st[2 * kk][0], st[2 * kk][1]); pw.y = cvtpk(st[2 * kk][2], st[2 * kk][3]); pw.z = cvtpk(st[2 * kk + 1][0], st[2 * kk + 1][1]); pw.w = cvtpk(st[2 * kk + 1][2], st[2 * kk + 1][3]);
        const bf16x8 pf = __builtin_bit_cast(bf16x8, pw);
        const int rowu = ((r0 + kk - vr0) * 64 + wsc) * 128;
#pragma unroll
        for (int dt = 0; dt < 4; ++dt) { const bf16x8 vf = cat8(trr(L + NA_VT + rowu + vsw[dt]), trr(L + NA_VT + rowu + 16 * 128 + vsw[dt])); o[dt] = MFMA16(vf, pf, o[dt]); }
    }
#pragma unroll
    for (int dt = 0; dt < 4; ++dt) { u32x2 w; w.x = cvtpk(o[dt][0] * inv, o[dt][1] * inv); w.y = cvtpk(o[dt][2] * inv, o[dt][3] * inv);
        *(u32x2*)(MIX + m * DM + h * 64 + 16 * dt + 4 * gq) = w; }
    LBAR();
}

constexpr int CV_GLU = 0, CV_BLK = 94 * 1024;
__device__ __forceinline__ void conf_fast_unit(const Args& a, const Ctx& X, int l, int unit) {
    const int b = unit >> 7, t0 = 64 * (unit & 127);
    const bf16_t* U = (const bf16_t*)(a.ws + WS_U); bf16_t* MIX = (bf16_t*)(a.ws + WS_MIX);
    LAS unsigned char* L = X.lds;
    {
        u32x4 aw[12], gw_[12];
#pragma unroll
        for (int i = 0; i < 12; ++i) { const int it = X.tid + 512 * i, j = it >> 6, cg = it & 63, t = t0 - 15 + j;
            aw[i] = (u32x4){0u, 0u, 0u, 0u}; gw_[i] = (u32x4){0u, 0u, 0u, 0u};
            if (it < 94 * 64 && t >= 0 && t < SEQ) { const bf16_t* p = U + (size_t)(b * SEQ + t) * NU + 8 * cg; aw[i] = *(const u32x4*)(p + U_CA); gw_[i] = *(const u32x4*)(p + U_CG); } }
#pragma unroll
        for (int i = 0; i < 12; ++i) { const int it = X.tid + 512 * i, j = it >> 6, cg = it & 63;
            float av[8], gv[8]; unpack8(aw[i], av); unpack8(gw_[i], gv);
#pragma unroll
            for (int e = 0; e < 8; ++e) av[e] *= sigmoidf_(gv[e]);
            u32x4 o; o.x = cvtpk(av[0], av[1]); o.y = cvtpk(av[2], av[3]); o.z = cvtpk(av[4], av[5]); o.w = cvtpk(av[6], av[7]);
            if (it < 94 * 64) *(LAS u32x4*)(L + CV_GLU + j * 1024 + cg * 16) = o; }
    }
    const int c = X.tid;
    float w[31];
    { const float* dw = a.in[15] + (size_t)l * 31 * 512 + c;
#pragma unroll
      for (int k = 0; k < 31; ++k) w[k] = dw[k * 512]; }
    const float bias = a.in[16][l * 512 + c];
    const f32x4 lw0 = *(const f32x4*)(a.in[17] + l * 512 + 8 * X.lane), lw1 = *(const f32x4*)(a.in[17] + l * 512 + 8 * X.lane + 4), lb0 = *(const f32x4*)(a.in[18] + l * 512 + 8 * X.lane), lb1 = *(const f32x4*)(a.in[18] + l * 512 + 8 * X.lane + 4);
    LBAR();
#pragma unroll 1
    for (int blk = 0; blk < 8; ++blk) {
        float acc[8];
#pragma unroll
        for (int o = 0; o < 8; ++o) acc[o] = bias;
#pragma unroll
        for (int jj = 0; jj < 38; ++jj) { const float v = bf1(*(const LAS bf16_t*)(L + CV_GLU + (8 * blk + jj) * 1024 + c * 2));
#pragma unroll
            for (int o = 0; o < 8; ++o) { const int k = jj - o; if (k >= 0 && k < 31) acc[o] += w[k] * v; } }
        LAS float* BL = (LAS float*)(L + CV_BLK + (blk & 1) * 16384);
#pragma unroll
        for (int o = 0; o < 8; ++o) BL[o * 512 + c] = acc[o];
        LBAR();
        const f32x4 x0 = *(const LAS f32x4*)(BL + X.wave * 512 + 8 * X.lane), x1 = *(const LAS f32x4*)(BL + X.wave * 512 + 8 * X.lane + 4);
        float x[8] = {x0[0], x0[1], x0[2], x0[3], x1[0], x1[1], x1[2], x1[3]};
        float s = 0.f;
#pragma unroll
        for (int e = 0; e < 8; ++e) s += x[e];
        const float mu = wsum(s) * (1.f / 512.f); float q = 0.f;
#pragma unroll
        for (int e = 0; e < 8; ++e) { x[e] -= mu; q += x[e] * x[e]; }
        const float rstd = rsqrtf(wsum(q) * (1.f / 512.f) + EPS);
        float y[8];
#pragma unroll
        for (int e = 0; e < 8; ++e) y[e] = siluf_(x[e] * rstd * (e < 4 ? lw0[e & 3] : lw1[e & 3]) + (e < 4 ? lb0[e & 3] : lb1[e & 3]));
        u32x4 ow; ow.x = cvtpk(y[0], y[1]); ow.y = cvtpk(y[2], y[3]); ow.z = cvtpk(y[4], y[5]); ow.w = cvtpk(y[6], y[7]);
        *(u32x4*)(MIX + (size_t)(b * SEQ + t0 + 8 * blk + X.wave) * DM + 1536 + 8 * X.lane) = ow;
    }
    LBAR();
}

#ifndef FAST_CONF
#define FAST_CONF 0
#endif
__device__ __forceinline__ void phase_mix_swa(const Args& a, const Ctx& X, int l) {
#if FAST_SWA
    SwaPre P; if (X.bid < 1024) swa_issue(a, X, X.bid, P);
#pragma unroll 1
    for (int un = X.bid; un < 1024; un += X.G) swa_fast_unit(a, X, l, un, P, un + X.G < 1024 ? un + X.G : -1);
#else
    LAS float* sc = (LAS float*)(X.lds + X.wave * 2048);
    for (int it = X.gw; it < T * 8; it += X.NGW) swa_slow_item(a, l, it >> 3, it & 7, sc, X.lane);
#endif
}
__device__ __forceinline__ void phase_mix_na(const Args& a, const Ctx& X, int l) {
#if FAST_NA
    NaPre P; if (X.bid < 1024) { na_issue<0>(a, X, X.bid, P); na_issue<1>(a, X, X.bid, P); }
#pragma unroll 1
    for (int un = X.bid; un < 1024; un += X.G) na_fast_unit(a, X, l, un, P, un + X.G < 1024 ? un + X.G : -1);
#else
    LAS float* sc = (LAS float*)(X.lds + X.wave * 2048);
    for (int it = X.gw; it < T * 8; it += X.NGW) na_slow_item(a, l, it >> 3, it & 7, sc, X.lane);
#endif
}
__device__ __forceinline__ void phase_mix_conf(const Args& a, const Ctx& X, int l) {
#if FAST_CONF
#pragma unroll 1
    for (int un = X.bid; un < 256; un += X.G) conf_fast_unit(a, X, l, un);
#else
    for (int it = X.gw; it < T; it += X.NGW) conf_slow_item(a, l, it, X.lane);
#endif
}
constexpr int PPL = 10;
constexpr int NPHASE = 1 + DEPTH * PPL + 1;

__global__ void __launch_bounds__(512, 2) fwd(Args args) {
    extern __shared__ __attribute__((aligned(16))) unsigned char lds_[];
    Ctx X;
#define MKCTX() do { int t_ = threadIdx.x; asm volatile("" : "+v"(t_)); X.lds = (LAS unsigned char*)lds_; X.tid = t_; X.lane = t_ & 63; X.wave = __builtin_amdgcn_readfirstlane(t_ >> 6); \
        int b_ = blockIdx.x; asm volatile("" : "+s"(b_)); X.G = gridDim.x; X.bid = b_; X.gw = X.bid * 8 + X.wave; X.NGW = X.G * 8; } while (0)
    MKCTX();
    volatile LAS unsigned* MISC = (volatile LAS unsigned*)(X.lds + MISC_OFF);
    for (int u = X.tid; u < 256; u += 512) ((LAS unsigned*)(X.lds + LDSCTL_OFF))[u] = 0u;
    __syncthreads();
    unsigned* barw = (unsigned*)(args.ws + WS_CTL) + CW_BAR;
    XcdBarrier bar; bar.bar = barw; bar.x = 0; bar.st = nullptr;
    if (!args.multi) bar = xcd_barrier_post(barw, MISC + 8);
    const int lo = args.ph_lo, hi = args.ph_hi;
#ifndef PROBE_PRE
#define PROBE_PRE 0
#endif
#ifndef RT_MFMA
#define RT_MFMA 1
#endif
#ifndef PROBE_OUTZ
#define PROBE_OUTZ 0
#endif
#ifndef PROBE_OUT
#define PROBE_OUT 0
#endif
#ifndef PROBE_GUCOLD
#define PROBE_GUCOLD 0
#endif
#ifndef SPLITSEAM
#define SPLITSEAM 0
#endif
#ifndef TOPK_IN_GU
#define TOPK_IN_GU 0
#endif
#ifndef TOPK_HANDOFF
#define TOPK_HANDOFF 0
#endif
#ifndef WAUX
#define WAUX 0
#endif
#ifndef PHMASK
#define PHMASK 0xfffff
#endif
#define IN(k) (lo <= (k) && (k) < hi)
#define EN(j) ((PHMASK >> (j)) & 1)
#ifndef REPMASK
#define REPMASK 0
#endif
#define REP(j) _Pragma("unroll 1") for (int rep_ = 0; rep_ < ((REPMASK >> (j)) & 1) + 1; ++rep_)
#ifndef BARREP
#define BARREP 1
#endif
#define SEAM(k) do { if ((k) + 1 < hi) { _Pragma("unroll 1") for (int br_ = 0; br_ < BARREP; ++br_) xcd_barrier(bar); } } while (0)
    const Args& a = args;
    LAS unsigned char* ring = X.lds;
    const LAS int* rmapL = (const LAS int*)(X.lds + RMAPL_OFF);

    if (EN(0) && IN(0)) { REP(0) { MKCTX(); phase_prologue(a, X); } MKCTX(); phase_pre(a, X, 0);
        if (!a.multi && X.wave == 0) xcd_barrier_census_wave(bar, lane_opq());
        SEAM(0); }

    for (int l = 0; l < DEPTH; ++l) {
        const int pb = 1 + l * PPL;
#if PROBE_PRE
        if (EN(1) && IN(pb + 0)) { MKCTX(); phase_pre(a, X, l, true); __syncthreads(); }
#endif
        if (EN(1) && IN(pb + 0) && l > 0) { MKCTX(); phase_pre(a, X, l); SEAM(pb + 0); }
        if (EN(2) && IN(pb + 1)) { REP(2) { MKCTX();
            pg8::Gemm g{(const bf16_t*)(a.ws + WS_XR), (const bf16_t*)(a.ws + WS_WIN) + (size_t)l * NU * DM, DM};
            pg8::StaticOrder S; S.init(T, NU, X.G, X.bid, 0);
            { const float* RS1 = (const float*)(a.ws + WS_RSTD1); LAS float* rs = (LAS float*)(X.lds + RSTDL_OFF);
              bool ok[8]; int pmv[8]; float rv[8];
#pragma unroll
              for (int ui = 0; ui < 8; ++ui) { pg8::Unit u; ok[ui] = S.next(ui, u); pmv[ui] = ok[ui] ? u.pm : 0; }
#pragma unroll
              for (int ui = 0; ui < 8; ++ui) rv[ui] = RS1[pmv[ui] * 256 + (X.tid & 255)];
#pragma unroll
              for (int ui = 0; ui < 8; ++ui) if (ok[ui] && X.tid < 256) rs[ui * 256 + X.tid] = rv[ui];
              __syncthreads(); }
            pg8::EpiU E{(bf16_t*)(a.ws + WS_U), (float*)(a.ws + WS_DTRAW), (const LAS float*)(X.lds + RSTDL_OFF)};
            pg8::gemm_phase<pg8::EpiU, pg8::StaticOrder, false>(ring, g, S, E, rmapL); }
            SEAM(pb + 1);
        }
#if FAST_SSD
        if (EN(3) && IN(pb + 2)) { REP(3) {
#ifndef SUBMASK
#define SUBMASK 15
#endif
            const bool s1_first = ((blockIdx.x >> 3) & 1) == 0;
            if ((SUBMASK & 1) && s1_first) REP(12) { MKCTX();
#pragma unroll 1
                for (int un = X.bid; un < 256; un += X.G) ssd_s1_unit(a, X, l, un);
                __syncthreads(); }
            const int ccls = (blockIdx.x >> 4) & 3; const bool cnext = LAZY_CONVERT && (JIT_CONVERT || l + 1 < DEPTH);
            if (cnext && ccls == 0) { MKCTX(); if (JIT_CONVERT) convert_jit(a, X, l); else convert_layer_weights(a, X, l + 1); __syncthreads(); }
            if (SUBMASK & 2) REP(13) { MKCTX(); phase_mix_swa(a, X, l); __syncthreads(); }
            if (cnext && ccls == 1) { MKCTX(); if (JIT_CONVERT) convert_jit(a, X, l); else convert_layer_weights(a, X, l + 1); __syncthreads(); }
            if (SUBMASK & 4) REP(14) { MKCTX(); phase_mix_na(a, X, l); __syncthreads(); }
            if (cnext && ccls == 2) { MKCTX(); if (JIT_CONVERT) convert_jit(a, X, l); else convert_layer_weights(a, X, l + 1); __syncthreads(); }
            if (SUBMASK & 8) REP(15) { MKCTX(); phase_mix_conf(a, X, l); __syncthreads(); }
            if (cnext && ccls == 3) { MKCTX(); if (JIT_CONVERT) convert_jit(a, X, l); else convert_layer_weights(a, X, l + 1); __syncthreads(); }
            if ((SUBMASK & 1) && !s1_first) { MKCTX();
#pragma unroll 1
                for (int un = X.bid; un < 256; un += X.G) ssd_s1_unit(a, X, l, un);
                __syncthreads(); } }
            SEAM(pb + 2); }
        if (EN(4) && IN(pb + 3)) { REP(4) { MKCTX(); phase_ssd_scan(a, X); } SEAM(pb + 3); }
        if (EN(5) && IN(pb + 4)) { REP(5) { MKCTX();
#pragma unroll 1
            for (int un = X.bid; un < 256; un += X.G) ssd_s3_unit(a, X, l, un); }
            SEAM(pb + 4); }
#else
        if (EN(3) && IN(pb + 2)) { MKCTX(); phase_ssd_prep(a, X, l); SEAM(pb + 2); }
        if (EN(4) && IN(pb + 3)) { MKCTX(); if (X.bid < 32) ssd_slow_unit(a, l, X.bid, X.tid); else { X.bid -= 32; X.G -= 32; X.gw = X.bid * 8 + X.wave; X.NGW = X.G * 8; phase_mix_swa(a, X, l); phase_mix_na(a, X, l); phase_mix_conf(a, X, l); } SEAM(pb + 3); }
        if (EN(5) && IN(pb + 4)) { MKCTX(); phase_ssd_fin_slow(a, X, l); SEAM(pb + 4); }
#endif
#if PROBE_OUT
        if (EN(6) && IN(pb + 5)) { MKCTX();
            pg8::Gemm g{(const bf16_t*)(a.ws + WS_MIX), (const bf16_t*)(a.ws + WS_WOUT) + (size_t)l * DM * DM, DM};
            pg8::StaticOrder S; S.init(T, DM, X.G, X.bid, 0);
            pg8::EpiRes E{(bf16_t*)(a.ws + WS_Y)};
            pg8::gemm_phase<pg8::EpiRes, pg8::StaticOrder, false>(ring, g, S, E, rmapL);
        }
#endif
        if (EN(6) && IN(pb + 5)) { MKCTX();
#if PROBE_OUTZ
            volatile LAS int* rc_ = (volatile LAS int*)(X.lds + MISC_OFF + 64);
            if (X.tid == 0) rc_[0] = 0;
            __syncthreads();
#pragma unroll 1
            for (;;) {
                const int r_ = __builtin_amdgcn_readfirstlane(rc_[0]);
                pg8::Gemm g{(const bf16_t*)(a.ws + WS_MIX), r_ == 0 ? (const bf16_t*)(a.ws + WS_END) : (const bf16_t*)(a.ws + WS_WOUT) + (size_t)l * DM * DM, DM};
                pg8::StaticOrder S; S.init(T, DM, X.G, X.bid, 0);
                pg8::EpiRes E{(bf16_t*)(a.ws + WS_XR)};
                pg8::gemm_phase<pg8::EpiRes, pg8::StaticOrder, false>(ring, g, S, E, rmapL);
                __syncthreads();
                if (r_ != 0) break;
                if (X.tid == 0) rc_[0] = 1;
                asm volatile("s_waitcnt vmcnt(0)" ::: "memory");
                __syncthreads();
            }
#else
            pg8::Gemm g{(const bf16_t*)(a.ws + WS_MIX), (const bf16_t*)(a.ws + WS_WOUT) + (size_t)l * DM * DM, DM};
            pg8::StaticOrder S; S.init(T, DM, X.G, X.bid, 0);
            pg8::EpiRes E{(bf16_t*)(a.ws + WS_XR)};
            pg8::gemm_phase<pg8::EpiRes, pg8::StaticOrder, false>(ring, g, S, E, rmapL);
#endif
            SEAM(pb + 5);
        }
#if TOPK_HANDOFF
        unsigned* cnt_rt = (unsigned*)(a.ws + WS_CTL) + 8192 + l * 128; unsigned* cnt_tk = cnt_rt + 64; unsigned* tmo_w = barw + XB_TMO;
        if (EN(7) && IN(pb + 6)) { MKCTX(); phase_router(a, X, l); wg_arrive(cnt_rt);
            if (X.bid < NB * NEXP) { wg_wait(cnt_rt, (unsigned)X.G, tmo_w); MKCTX(); phase_topk(a, X); wg_arrive(cnt_tk); } }
#else
        if (EN(7) && IN(pb + 6)) { REP(7) { MKCTX(); if (RT_MFMA) phase_router_mfma(a, X, l); else phase_router(a, X, l); } SEAM(pb + 6); }
#if !TOPK_IN_GU
        if (EN(8) && IN(pb + 7)) { REP(8) { MKCTX(); phase_topk(a, X); if (LAZY_CONVERT && JIT_CONVERT && l + 1 < DEPTH) convert_in_topk(a, X, l); __syncthreads(); } SEAM(pb + 7); }
#endif
#endif
        if (EN(9) && IN(pb + 8)) { REP(9) { MKCTX();
            pg8::Gemm g{(const bf16_t*)(a.ws + WS_XR), (const bf16_t*)(a.ws + WS_WGU) + (size_t)l * NEXP * 2048 * DM, DM};
            pg8::StaticOrder S; S.init(NSLOT, 2048, X.G, X.bid, 8);
#if TOPK_HANDOFF
            wg_wait(cnt_tk, (unsigned)(NB * NEXP), tmo_w);
#endif
#if TOPK_IN_GU
            { LAS int* rl = (LAS int*)(X.lds + RMAPL_OFF); pg8::Unit u; int ui = 0;
              while (ui < 8 && S.next(ui, u)) { const int pm = u.pm; int n = 1; pg8::Unit u2; bool pn0 = (u.pn == 0);
                  while (ui + n < 8 && S.next(ui + n, u2) && u2.pm == pm) { pn0 = pn0 || (u2.pn == 0); ++n; }
                  const bool pub = ((pm & 3) == 0) && pn0;
                  topk_run(a, X, ((pm >> 2) & 1) * 16 + (pm >> 3), pub, rl + ui * 256, n, (pm & 3) * 256);
                  for (int q = 2; q < n; ++q) { if (X.tid < 256) rl[(ui + q) * 256 + X.tid] = rl[ui * 256 + X.tid]; }
                  ui += n; }
              __syncthreads(); }
#else
            { const int* RMAP = (const int*)(a.ws + WS_RMAP); LAS int* rl = (LAS int*)(X.lds + RMAPL_OFF);
              const float* RSTD = (const float*)(a.ws + WS_RSTD); LAS float* rs = (LAS float*)(X.lds + RSTDL_OFF);
              bool ok[8]; int pmv[8], tok[8]; float rv[8];
#pragma unroll
              for (int ui = 0; ui < 8; ++ui) { pg8::Unit u; ok[ui] = S.next(ui, u); pmv[ui] = ok[ui] ? u.pm : 0; }
#pragma unroll
              for (int ui = 0; ui < 8; ++ui) tok[ui] = RMAP[pmv[ui] * 256 + (X.tid & 255)];
#pragma unroll
              for (int ui = 0; ui < 8; ++ui) rv[ui] = RSTD[tok[ui]];
#pragma unroll
              for (int ui = 0; ui < 8; ++ui) if (ok[ui] && X.tid < 256) { rl[ui * 256 + X.tid] = tok[ui]; rs[ui * 256 + X.tid] = rv[ui]; }
              __syncthreads(); }
#endif
            pg8::EpiSwiglu E{(bf16_t*)(a.ws + WS_HID), (const LAS float*)(X.lds + RSTDL_OFF)};
            pg8::gemm_phase<pg8::EpiSwiglu, pg8::StaticOrder, true, WAUX>(ring, g, S, E, rmapL); }
            SEAM(pb + 8);
        }
#if PROBE_GUCOLD
        if (EN(9) && IN(pb + 8)) { MKCTX();
            pg8::Gemm g{(const bf16_t*)(a.ws + WS_HN), (const bf16_t*)(a.ws + WS_WGU) + (size_t)((l + 1) & 3) * NEXP * 2048 * DM, DM};
            pg8::StaticOrder S; S.init(NSLOT, 2048, X.G, X.bid, 8);
            pg8::EpiSwiglu E{(bf16_t*)(a.ws + WS_END)};
            pg8::gemm_phase<pg8::EpiSwiglu, pg8::StaticOrder, true>(ring, g, S, E, rmapL);
        }
#endif
        if (EN(10) && IN(pb + 9)) { REP(10) { MKCTX();
            pg8::Gemm g{(const bf16_t*)(a.ws + WS_HID), (const bf16_t*)(a.ws + WS_WDN) + (size_t)l * NEXP * 2048 * FF, FF};
            pg8::StaticOrder S; S.init(NSLOT, 2048, X.G, X.bid, 8);
            pg8::EpiDown E{(bf16_t*)(a.ws + WS_Y), (const float*)(a.ws + WS_GATE)};
            pg8::gemm_phase<pg8::EpiDown, pg8::StaticOrder, false, WAUX>(ring, g, S, E, rmapL); }
            SEAM(pb + 9);
        }
    }
    if (EN(11) && IN(1 + DEPTH * PPL)) { MKCTX(); phase_pre(a, X, DEPTH); }
#undef IN
#undef SEAM
}

extern "C" void kernel_launch(void* const* d_in, const int* in_sizes, int n_in, void* d_out, int out_size, void* d_ws, size_t ws_size, hipStream_t stream) {
    static int grid = 0;
    if (grid == 0) {
        if (n_in != 25 || in_sizes[0] != T * DM || out_size != T * DM || ws_size < WS_END + PROBE_GUCOLD * 64 * MiB) { fprintf(stderr, "kernel_launch: unexpected shapes (n_in %d, in0 %d, out %d, ws %zu < %zu); nothing launched\n", n_in, n_in > 0 ? in_sizes[0] : -1, out_size, ws_size, (size_t)WS_END); grid = -1; return; }
        int dev = 0, cus = 0, per_cu = 0;
        if (hipGetDevice(&dev) != hipSuccess || hipDeviceGetAttribute(&cus, hipDeviceAttributeMultiprocessorCount, dev) != hipSuccess) { grid = -1; return; }
        if (hipFuncSetAttribute((const void*)fwd, hipFuncAttributeMaxDynamicSharedMemorySize, LDS_BYTES) != hipSuccess) { fprintf(stderr, "kernel_launch: hipFuncSetAttribute failed\n"); grid = -1; return; }
        if (hipOccupancyMaxActiveBlocksPerMultiprocessor(&per_cu, (const void*)fwd, 512, LDS_BYTES) != hipSuccess || per_cu < 1) { fprintf(stderr, "kernel_launch: occupancy query reports %d blocks per CU\n", per_cu); }
        (void)hipGetLastError();
        grid = cus;
        if (grid < 128) { fprintf(stderr, "kernel_launch: needs >= 128 CUs\n"); grid = -1; return; }
    }
    if (grid < 0) return;
    if (hipMemsetAsync((char*)d_ws + WS_CTL, 0, CTL_ZERO_BYTES, stream) != hipSuccess) return;
#if PROBE_OUTZ
    if (hipMemsetAsync((char*)d_ws + WS_END, 0, (size_t)DM * DM * 2, stream) != hipSuccess) return;
#endif
    Args a{};
    for (int i = 0; i < 25; ++i) a.in[i] = (const float*)d_in[i];
    a.out = (float*)d_out; a.ws = (unsigned char*)d_ws; a.pad = 0;
#if MK_MULTI
    for (int p = 0; p < NPHASE; ++p) { a.ph_lo = p; a.ph_hi = p + 1; a.multi = 1; hipLaunchKernelGGL(fwd, dim3(grid), dim3(512), LDS_BYTES, stream, a); }
#else
    a.ph_lo = 0; a.ph_hi = NPHASE; a.multi = 0;
    hipLaunchKernelGGL(fwd, dim3(grid), dim3(512), LDS_BYTES, stream, a);
#endif
}
```
